# Optimizing an MI355X kernel written in HIP

```python
import math
import jax, jax.numpy as jnp
from jax import lax
import numpy as np

D_MODEL = 4096
BATCH = 8
SEQ = 2048
DEPTH = 2

HEAD_DIM = 128
ATTN_HEADS = 16
KV_GROUPS = 2
HEADS_PER_GROUP = ATTN_HEADS // KV_GROUPS
ATTN_WIDTH = ATTN_HEADS * HEAD_DIM
KV_WIDTH = KV_GROUPS * HEAD_DIM
ROPE_DIM = HEAD_DIM // 4
ROPE_THETA = 500000.0
CMP_BLOCK = 32
CMP_STRIDE = 16
SLC_BLOCK = 32
SLC_TOPN = 8
WINDOW = 512
Q_BLOCK = 128
SLC_Q_CHUNK = 64

HG_HEADS = 8
HG_DK = 128
HG_DV = 128
HG_KWIDTH = HG_HEADS * HG_DK
HG_WIDTH = HG_HEADS * HG_DV
HG_CHUNK = 16

POOL_WINDOWS = (2, 4, 8, 16)
POOL_GROUP = 256
POOL_WIDTH = POOL_GROUP * len(POOL_WINDOWS)

N_BRANCH = 3
SPLIT_SIZES = (ATTN_WIDTH, KV_WIDTH, KV_WIDTH, KV_WIDTH, KV_WIDTH, KV_WIDTH, KV_WIDTH, 3 * ATTN_HEADS,
               HG_KWIDTH, HG_KWIDTH, HG_WIDTH, HG_WIDTH, POOL_WIDTH, D_MODEL, D_MODEL, D_MODEL)
N_IN = sum(SPLIT_SIZES)

N_EXPERTS = 64
TOP_K = 8
D_EXPERT = 128
D_SHARED = 256
ROUTE_SCALE = 2.5

DN_ALPHA = (2.0 * DEPTH) ** 0.25
DN_BETA = (8.0 * DEPTH) ** -0.25
LN_EPS = 1e-5
RMS_EPS = 1e-6

kernel_name = "hybrid_nsa_hgrn2_pool_moe_deepnorm"

F32 = jnp.float32


def layer_norm(x, g, b):
    xf = x.astype(F32)
    mu = jnp.mean(xf, -1, keepdims=True)
    var = jnp.mean(jnp.square(xf - mu), -1, keepdims=True)
    return ((xf - mu) * lax.rsqrt(var + LN_EPS) * g.astype(F32) + b.astype(F32)).astype(x.dtype)


def partial_rope(x, positions):
    half = ROPE_DIM // 2
    inv = ROPE_THETA ** (-jnp.arange(half, dtype=F32) * 2.0 / ROPE_DIM)
    ang = positions.astype(F32)[..., None] * inv
    cos = jnp.cos(ang)[:, :, None, :]
    sin = jnp.sin(ang)[:, :, None, :]
    xf = x.astype(F32)
    x1 = xf[..., :half]
    x2 = xf[..., half:ROPE_DIM]
    out = jnp.concatenate([x1 * cos - x2 * sin, x2 * cos + x1 * sin, xf[..., ROPE_DIM:]], -1)
    return out.astype(x.dtype)


def compress_tokens(t, pos_emb, w1, w2):
    B, S, G, d = t.shape
    n_cmp = (S - CMP_BLOCK) // CMP_STRIDE + 1
    idx = jnp.arange(n_cmp)[:, None] * CMP_STRIDE + jnp.arange(CMP_BLOCK)[None, :]
    blk = t[:, idx] + pos_emb[:, None, :]
    flat = jnp.moveaxis(blk, 3, 2).reshape(B, n_cmp, G, CMP_BLOCK * d)
    return jax.nn.gelu(flat @ w1) @ w2


def nsa_attention(q, kc, vc, ks, vs, kw, vw, gate, positions, cpk, cpv, cw1k, cw2k, cw1v, cw2v):
    B, S = q.shape[:2]
    G, HPG, d = KV_GROUPS, HEADS_PER_GROUP, HEAD_DIM
    scale = d ** -0.5
    t_idx = jnp.arange(S)

    kcmp = compress_tokens(kc, cpk, cw1k, cw2k)
    vcmp = compress_tokens(vc, cpv, cw1v, cw2v)
    n_cmp = kcmp.shape[1]
    qg = q.reshape(B, S, G, HPG, d)
    s_c = jnp.einsum('bsghd,bcgd->bghsc', qg, kcmp, preferred_element_type=F32) * scale
    cmp_end = jnp.arange(n_cmp) * CMP_STRIDE + CMP_BLOCK - 1
    vis_c = cmp_end[None, :] <= t_idx[:, None]
    p_c = jax.nn.softmax(jnp.where(vis_c, s_c, -1e30), -1) * vis_c
    o_c = jnp.einsum('bghsc,bcgd->bsghd', p_c.astype(q.dtype), vcmp)

    n_slc = S // SLC_BLOCK
    cs = jnp.arange(n_cmp) * CMP_STRIDE
    ss = jnp.arange(n_slc) * SLC_BLOCK
    overlap = jnp.clip(jnp.minimum(cs[:, None] + CMP_BLOCK, ss[None, :] + SLC_BLOCK)
                       - jnp.maximum(cs[:, None], ss[None, :]), 0) / CMP_STRIDE
    imp = jnp.einsum('bghsc,cn->bgsn', p_c, overlap.astype(F32))
    blk = jnp.arange(n_slc)
    blk_t = t_idx // SLC_BLOCK
    causal_blk = blk[None, :] <= blk_t[:, None]
    forced = (blk[None, :] == 0) | (blk[None, :] == blk_t[:, None]) | (blk[None, :] == blk_t[:, None] - 1)
    imp = jnp.where(forced, jnp.inf, jnp.where(causal_blk, imp, -jnp.inf))
    k_top = min(SLC_TOPN, n_slc)
    _, sel = lax.top_k(imp, k_top)
    sel_ok = jnp.take_along_axis(jnp.broadcast_to(causal_blk, (B, G, S, n_slc)), sel, -1)

    qs = partial_rope(q, positions)
    ks_r = partial_rope(ks, positions)
    kw_r = partial_rope(kw, positions)

    ks_blk = jnp.moveaxis(ks_r.reshape(B, n_slc, SLC_BLOCK, G, d), 3, 1)
    vs_blk = jnp.moveaxis(vs.reshape(B, n_slc, SLC_BLOCK, G, d), 3, 1)
    n_ch = S // SLC_Q_CHUNK
    q_ch = jnp.moveaxis(qs.reshape(B, n_ch, SLC_Q_CHUNK, G, HPG, d), 1, 0)
    sel_ch = jnp.moveaxis(sel.reshape(B, G, n_ch, SLC_Q_CHUNK, k_top), 2, 0)
    ok_ch = jnp.moveaxis(sel_ok.reshape(B, G, n_ch, SLC_Q_CHUNK, k_top), 2, 0)
    t_ch = t_idx.reshape(n_ch, SLC_Q_CHUNK)
    bi = jnp.arange(B)[:, None, None, None]
    gi = jnp.arange(G)[None, :, None, None]
    key_off = jnp.arange(SLC_BLOCK)

    def slc_chunk(args):
        qc, sc, okc, tc = args
        kg = ks_blk[bi, gi, sc]
        vg = vs_blk[bi, gi, sc]
        s = jnp.einsum('bqghd,bgqkld->bghqkl', qc, kg, preferred_element_type=F32) * scale
        kpos = sc[..., None] * SLC_BLOCK + key_off
        m = okc[..., None] & (kpos <= tc[None, None, :, None, None])
        s = jnp.where(m[:, :, None], s, -1e30)
        p = jax.nn.softmax(s.reshape(*s.shape[:4], -1), -1).reshape(s.shape)
        return jnp.einsum('bghqkl,bgqkld->bqghd', p.astype(qc.dtype), vg)

    o_s = lax.map(slc_chunk, (q_ch, sel_ch, ok_ch, t_ch))
    o_s = jnp.moveaxis(o_s, 0, 1).reshape(B, S, G, HPG, d)

    n_qb = S // Q_BLOCK
    span = WINDOW + Q_BLOCK
    kw_pad = jnp.pad(kw_r, ((0, 0), (WINDOW, 0), (0, 0), (0, 0)))
    vw_pad = jnp.pad(vw, ((0, 0), (WINDOW, 0), (0, 0), (0, 0)))
    qs_g = qs.reshape(B, S, G, HPG, d)

    def win_block(i):
        start = i * Q_BLOCK
        qb = lax.dynamic_slice_in_dim(qs_g, start, Q_BLOCK, axis=1)
        kb = lax.dynamic_slice_in_dim(kw_pad, start, span, axis=1)
        vb = lax.dynamic_slice_in_dim(vw_pad, start, span, axis=1)
        tq = start + jnp.arange(Q_BLOCK)
        tk = start - WINDOW + jnp.arange(span)
        m = (tk[None, :] >= 0) & (tk[None, :] <= tq[:, None]) & (tq[:, None] - tk[None, :] < WINDOW)
        s = jnp.einsum('bqghd,bkgd->bghqk', qb, kb, preferred_element_type=F32) * scale
        p = jax.nn.softmax(jnp.where(m, s, -1e30), -1)
        return jnp.einsum('bghqk,bkgd->bqghd', p.astype(qb.dtype), vb)

    o_w = lax.map(win_block, jnp.arange(n_qb))
    o_w = jnp.moveaxis(o_w, 0, 1).reshape(B, S, G, HPG, d)

    g = jax.nn.sigmoid(gate.astype(F32)).reshape(B, S, 3, G, HPG)[..., None].astype(q.dtype)
    o = g[:, :, 0] * o_c + g[:, :, 1] * o_s + g[:, :, 2] * o_w
    return o.reshape(B, S, ATTN_WIDTH)


def hgrn2(hq, hf, hi, hg, lb, norm_g):
    B, S, _ = hq.shape
    H, K, V, C = HG_HEADS, HG_DK, HG_DV, HG_CHUNK
    f = lb + (1.0 - lb) * jax.nn.sigmoid(hf.astype(F32))
    log_f = jnp.log(f)
    k = 1.0 - f
    q = hq.astype(F32)
    v = hi.astype(F32)
    n_c = S // C

    def to_chunks(t, w):
        return jnp.moveaxis(t.reshape(B, n_c, C, H, w), 1, 0).transpose(0, 1, 3, 2, 4)

    causal = jnp.tril(jnp.ones((C, C), bool))

    def step(state, inp):
        qc, kc, vc, lfc = inp
        b = jnp.cumsum(lfc, axis=2)
        diff = b[:, :, :, None, :] - b[:, :, None, :, :]
        dec = jnp.exp(jnp.where(causal[:, :, None], diff, -jnp.inf))
        a = jnp.einsum('bhtk,bhsk,bhtsk->bhts', qc, kc, dec)
        o = jnp.einsum('bhts,bhsv->bhtv', a, vc) + jnp.einsum('bhtk,bhkv->bhtv', qc * jnp.exp(b), state)
        b_last = b[:, :, -1:, :]
        new_state = jnp.exp(b_last[:, :, 0])[..., None] * state + jnp.einsum('bhsk,bhsv->bhkv', kc * jnp.exp(b_last - b), vc)
        return new_state, o

    s0 = jnp.zeros((B, H, K, V), F32)
    _, o = lax.scan(step, s0, (to_chunks(q, K), to_chunks(k, K), to_chunks(v, V), to_chunks(log_f, K)))
    o = o.transpose(1, 0, 3, 2, 4).reshape(B, S, H, V)
    o = o * lax.rsqrt(jnp.mean(jnp.square(o), -1, keepdims=True) + RMS_EPS) * norm_g.astype(F32).reshape(H, V)
    o = o * jax.nn.silu(hg.astype(F32).reshape(B, S, H, V))
    return o.reshape(B, S, HG_WIDTH).astype(hq.dtype)


def multiscale_pool(p, w_pool, scale):
    B, S, W = p.shape
    pf = p.astype(F32)
    csum = jnp.concatenate([jnp.zeros((B, 1, W), F32), jnp.cumsum(pf, axis=1)], axis=1)
    t = jnp.arange(S)
    outs = []
    for gi, w in enumerate(POOL_WINDOWS):
        sl = slice(gi * POOL_GROUP, (gi + 1) * POOL_GROUP)
        cg = csum[..., sl]
        lo = jnp.maximum(t + 1 - w, 0)
        cnt = (t + 1 - lo).astype(F32)
        mixed = (cg[:, t + 1] - cg[:, lo]) / cnt[None, :, None] - pf[..., sl]
        outs.append(jnp.einsum('bsc,cd->bsd', mixed.astype(p.dtype), w_pool[gi]))
    return jnp.concatenate(outs, -1) * scale


def moe(x, router_w, router_b, w1, w3, w2, ws1, ws3, ws2):
    B, S, D = x.shape
    xf = x.reshape(-1, D)
    scores = jax.nn.sigmoid(jnp.matmul(xf, router_w, preferred_element_type=F32))
    _, idx = lax.top_k(scores + router_b.astype(F32), TOP_K)
    w = jnp.take_along_axis(scores, idx, -1)
    w = w / jnp.sum(w, -1, keepdims=True) * ROUTE_SCALE
    gate = jnp.sum(jax.nn.one_hot(idx, N_EXPERTS, dtype=F32) * w[..., None], axis=1)
    hdn = jax.nn.silu(jnp.einsum('nd,edf->nef', xf, w1)) * jnp.einsum('nd,edf->nef', xf, w3)
    routed = jnp.einsum('nef,efd->nd', hdn * gate[..., None].astype(xf.dtype), w2)
    shared = (jax.nn.silu(xf @ ws1) * (xf @ ws3)) @ ws2
    return (routed + shared).reshape(B, S, D)


def setup_inputs(seed: int = 0) -> dict:
    key = jax.random.key(seed)
    ks = jax.random.split(key, 32)
    L, D, d = DEPTH, D_MODEL, HEAD_DIM
    nrm = lambda k, shape, s: jax.random.normal(k, shape, F32) * s
    return {
        "x": nrm(ks[0], (BATCH, SEQ, D), 1.0),
        "positions": jnp.broadcast_to(jnp.arange(SEQ, dtype=jnp.int32), (BATCH, SEQ)),
        "ln_in_g": 1.0 + nrm(ks[1], (D,), 0.02),
        "ln_in_b": nrm(ks[2], (D,), 0.02),
        "w_in": nrm(ks[3], (L, D, N_IN), D ** -0.5),
        "cmp_pos_k": nrm(ks[4], (L, CMP_BLOCK, d), 0.02),
        "cmp_pos_v": nrm(ks[5], (L, CMP_BLOCK, d), 0.02),
        "cmp_w1_k": nrm(ks[6], (L, CMP_BLOCK * d, d), (CMP_BLOCK * d) ** -0.5),
        "cmp_w2_k": nrm(ks[7], (L, d, d), d ** -0.5),
        "cmp_w1_v": nrm(ks[8], (L, CMP_BLOCK * d, d), (CMP_BLOCK * d) ** -0.5),
        "cmp_w2_v": nrm(ks[9], (L, d, d), d ** -0.5),
        "hg_lb_logits": nrm(ks[10], (L, HG_KWIDTH), 1.0),
        "hg_norm_g": 1.0 + nrm(ks[11], (L, HG_WIDTH), 0.02),
        "pool_w": nrm(ks[12], (L, len(POOL_WINDOWS), POOL_GROUP, POOL_GROUP), POOL_GROUP ** -0.5),
        "pool_scale": 1.0 + nrm(ks[13], (L, POOL_WIDTH), 0.02),
        "w_up_attn": nrm(ks[14], (L, ATTN_WIDTH, D), ATTN_WIDTH ** -0.5 * DN_BETA),
        "w_up_hg": nrm(ks[15], (L, HG_WIDTH, D), HG_WIDTH ** -0.5 * DN_BETA),
        "w_up_pool": nrm(ks[16], (L, POOL_WIDTH, D), POOL_WIDTH ** -0.5 * DN_BETA),
        "w_o": nrm(ks[17], (L, D, D), D ** -0.5 * DN_BETA),
        "ln1_g": 1.0 + nrm(ks[18], (L, D), 0.02),
        "ln1_b": nrm(ks[19], (L, D), 0.02),
        "router_w": nrm(ks[20], (L, D, N_EXPERTS), D ** -0.5),
        "router_b": nrm(ks[21], (L, N_EXPERTS), 0.01),
        "w1": nrm(ks[22], (L, N_EXPERTS, D, D_EXPERT), D ** -0.5),
        "w3": nrm(ks[23], (L, N_EXPERTS, D, D_EXPERT), D ** -0.5),
        "w2": nrm(ks[24], (L, N_EXPERTS, D_EXPERT, D), D_EXPERT ** -0.5 * DN_BETA),
        "ws1": nrm(ks[25], (L, D, D_SHARED), D ** -0.5),
        "ws3": nrm(ks[26], (L, D, D_SHARED), D ** -0.5),
        "ws2": nrm(ks[27], (L, D_SHARED, D), D_SHARED ** -0.5 * DN_BETA),
        "ln2_g": 1.0 + nrm(ks[28], (L, D), 0.02),
        "ln2_b": nrm(ks[29], (L, D), 0.02),
    }


def reference(x, positions, ln_in_g, ln_in_b, w_in, cmp_pos_k, cmp_pos_v, cmp_w1_k, cmp_w2_k, cmp_w1_v, cmp_w2_v,
              hg_lb_logits, hg_norm_g, pool_w, pool_scale, w_up_attn, w_up_hg, w_up_pool, w_o, ln1_g, ln1_b,
              router_w, router_b, w1, w3, w2, ws1, ws3, ws2, ln2_g, ln2_b):
    B, S, D = x.shape
    lbs = jnp.cumsum(jax.nn.softmax(hg_lb_logits.astype(F32), axis=0), axis=0)
    lbs = lbs - lbs[0:1]
    split_points = [int(v) for v in np.cumsum(SPLIT_SIZES)[:-1]]
    h = layer_norm(x, ln_in_g, ln_in_b)
    for l in range(DEPTH):
        proj = jnp.matmul(h, w_in[l])
        (q, kc, vc, ks_, vs_, kw, vw, a_gate, hq, hf, hi, hg, pin, ga, gb, gc) = jnp.split(proj, split_points, axis=-1)
        kv = lambda t: t.reshape(B, S, KV_GROUPS, HEAD_DIM)
        ya = nsa_attention(q.reshape(B, S, ATTN_HEADS, HEAD_DIM), kv(kc), kv(vc), kv(ks_), kv(vs_), kv(kw), kv(vw),
                           a_gate, positions, cmp_pos_k[l], cmp_pos_v[l], cmp_w1_k[l], cmp_w2_k[l],
                           cmp_w1_v[l], cmp_w2_v[l])
        yb = hgrn2(hq, hf, hi, hg, lbs[l], hg_norm_g[l])
        yc = multiscale_pool(pin, pool_w[l], pool_scale[l])
        merged = (jax.nn.sigmoid(ga) * (ya @ w_up_attn[l])
                  + jax.nn.sigmoid(gb) * (yb @ w_up_hg[l])
                  + jax.nn.sigmoid(gc) * (yc @ w_up_pool[l]))
        h = layer_norm(DN_ALPHA * h + merged @ w_o[l], ln1_g[l], ln1_b[l])
        ffn = moe(h, router_w[l], router_b[l], w1[l], w3[l], w2[l], ws1[l], ws3[l], ws2[l])
        h = layer_norm(DN_ALPHA * h + ffn, ln2_g[l], ln2_b[l])
    return h
```

```cpp
#include <hip/hip_runtime.h>
#include <cstdio>
#include <cstdint>

#define GAS __attribute__((address_space(1)))
#define LAS __attribute__((address_space(3)))
typedef unsigned short bf16;
typedef unsigned u32x4 __attribute__((ext_vector_type(4)));
typedef unsigned u32x2 __attribute__((ext_vector_type(2)));
typedef float f32x4 __attribute__((ext_vector_type(4)));
typedef float f32x2 __attribute__((ext_vector_type(2)));
typedef short bf16x8 __attribute__((ext_vector_type(8)));
typedef GAS unsigned gu32;

#ifndef MK_P1_ALLI8
#define MK_P1_ALLI8 1
#endif
constexpr int NTOK = 16384, SEQ = 2048, BATCH = 8, DM = 4096, DEPTH = 2;
constexpr int PLD = 21248;
constexpr int NIN_SRC = 21040;
constexpr int C_Q = 0, C_KC = 2048, C_VC = 2304, C_KS = 2560, C_VS = 2816, C_KW = 3072, C_VW = 3328, C_HQ = 3584, C_HF = 4608, C_HI = 5632, C_HG = 6656,
              C_PIN = 7680, C_GA = 8704, C_GB = 12800, C_GC = 16896, C_AG = 20992;
constexpr int NEXP = 64, TOPK = 8, DEXP = 128, DSH = 256, NPAIR = NTOK * TOPK, PCAP = NTOK;
constexpr float LN_EPS = 1e-5f, RMS_EPS = 1e-6f;
constexpr float DN_ALPHA = 1.4142135623730951f;
constexpr float ATT_SCALE = 0.08838834764831845f;
constexpr float LOG2E = 1.4426950408889634f;

constexpr size_t MiB = 1u << 20;
constexpr size_t WS_CTL = 0, CTL_ZERO_BYTES = 1 * MiB;
constexpr int W8LD = 4224;
constexpr int WLD = 4160;
constexpr size_t WS_WIN = 1 * MiB, WS_WUP = 170 * MiB, WS_WO = 203 * MiB, WS_W13 = 236 * MiB, WS_W2 = 366 * MiB, WS_WS13 = 430 * MiB, WS_WS2 = 435 * MiB,
                 WS_CW1 = 437 * MiB, WS_SMALL = 440 * MiB, WS_ROUTER = 441 * MiB, WS_ROPE = 444 * MiB, WS_KCMP = 446 * MiB, WS_VST = 447 * MiB, WS_VWT = 455 * MiB,
                 WS_SEL = 463 * MiB, WS_LOGIT = 464 * MiB, WS_PLIST = 480 * MiB, WS_PGATE = 484 * MiB, WS_HD = 485 * MiB, WS_HS = 517 * MiB, WS_HB = 525 * MiB,
                 WS_YPRE = 653 * MiB, WS_PROJ = 909 * MiB, WS_QS = 1573 * MiB, WS_YAF = 1637 * MiB, WS_OHG = 1765 * MiB, WS_MIXED = 1829 * MiB, WS_Y = 1861 * MiB,
                 WS_MERGED = 1989 * MiB, WS_YAF2 = 2117 * MiB, WS_KST = 2245 * MiB, WS_KWT = 2253 * MiB, WS_PGS = 2261 * MiB, WS_HD2 = 2265 * MiB, WS_HB8 = 2305 * MiB, WS_HBS = 2419 * MiB, WS_W8S = 2420 * MiB, WS_W8 = 2421 * MiB, WS_W138 = 2507 * MiB, WS_WS138 = 2573 * MiB, WS_WUP8 = 2576 * MiB, WS_WO8 = 2593 * MiB, WS_END = 2610 * MiB;
constexpr size_t WS_OHG2 = WS_MERGED;
static_assert(WS_WIN + (size_t)PLD * WLD * 2 <= WS_WUP && WS_W13 + (size_t)NEXP * 256 * WLD * 2 <= WS_W2 && WS_WS13 + (size_t)512 * WLD * 2 <= WS_WS2 && WS_CW1 + (size_t)256 * WLD * 2 <= WS_SMALL && WS_ROUTER + (size_t)256 * WLD * 2 <= WS_ROPE && WS_WUP + (size_t)4096 * WLD * 2 <= WS_WO && WS_WO + (size_t)4096 * WLD * 2 <= WS_W13, "weight regions");
constexpr size_t WS_Y8 = WS_YAF, WS_M8 = WS_YAF2;
constexpr size_t WS_YPAIR = WS_PROJ;
static_assert(WS_YPAIR + (size_t)NPAIR * DM * 2 <= WS_END, "Ypair overlay");
static_assert(WS_PROJ + (size_t)NTOK * PLD * 2 == WS_QS, "proj size");
constexpr size_t SM_CW2 = 0, SM_POOL = 65536, SM_BIAS1 = 655360;
constexpr int CW_TMO = 0, CW_BAR = 4096, CW_CNT = 16384;

constexpr int RING_BYTES = 139264;
constexpr int LDSCTL_OFF = RING_BYTES, MISC_OFF = LDSCTL_OFF + 320;
constexpr int LDS_BYTES = 147456;
constexpr int NWAVES = 8;

#define LDS_WAIT() asm volatile("s_waitcnt lgkmcnt(0)" ::: "memory")
#define VM_WAIT() asm volatile("s_waitcnt vmcnt(0)" ::: "memory")
__device__ __forceinline__ unsigned f2bf(float f) { unsigned u = __builtin_bit_cast(unsigned, f); return (u + 0x7fffu + ((u >> 16) & 1u)) >> 16; }
__device__ __forceinline__ unsigned pk2(float lo, float hi) { return f2bf(lo) | (f2bf(hi) << 16); }
__device__ __forceinline__ float bflo(unsigned w) { return __uint_as_float(w << 16); }
__device__ __forceinline__ float bfhi(unsigned w) { return __uint_as_float(w & 0xffff0000u); }
__device__ __forceinline__ float bf1(bf16 b) { return __uint_as_float(((unsigned)b) << 16); }
__device__ __forceinline__ float sigmoidf_(float x) { return 1.0f / (1.0f + __expf(-x)); }
__device__ __forceinline__ float siluf_(float x) { return x / (1.0f + __expf(-x)); }
__device__ __forceinline__ float wave_sum(float v) {
#pragma unroll
    for (int o = 1; o < 64; o <<= 1) v += __shfl_xor(v, o);
    return v;
}
namespace pg8 {
#define PG8_LAS __attribute__((address_space(3)))
constexpr int BM = 256, BK = 64, HALF = 128, HTB = HALF * BK * 2  , STAGE_BYTES = 8 * HTB, NXCD = 8, WGM = 8;

__host__ __device__ __forceinline__ int lds_byte(int r, int c) { const int st = (r >> 4) * 2 + (c >> 5), rr = r & 15, cc = c & 31, ob = rr * 64 + cc * 2; return st * 1024 + (ob ^ (((ob >> 9) & 1) << 5)); }
__host__ __device__ __forceinline__ void stage_rc(int b, int& R, int& C) { const int st = b / 1024, sb = b % 1024, swz = sb ^ (((sb >> 9) & 1) << 5); R = (st >> 1) * 16 + swz / 64; C = (st & 1) * 32 + (swz % 64) / 2; }
__host__ __device__ __forceinline__ int perm32(int rho) { const int n = rho >> 4, i = rho & 15; return 8 * (i >> 2) + 4 * n + (i & 3); }

struct Unit {
    const char* A;
    const char* B;
    const int* rows;
    int nt;
    int epi;
    int pm, pn, aux;
    int nvalid, rowbase, shift;
};

struct TileOrder {
    int nM, nN, nwg;
    __device__ __forceinline__ void init(int nM_, int nN_) { nM = nM_; nN = nN_; nwg = nM * nN; }
    __device__ __forceinline__ bool tile(long L, int& pm, int& pn) const {
        if (L >= nwg) return false;
        int wgid = (int)L; { const int q = nwg / NXCD, r = nwg % NXCD, xcd = wgid % NXCD, off = wgid / NXCD; wgid = (xcd < r ? xcd * (q + 1) : r * (q + 1) + (xcd - r) * q) + off; }
        const int nig = WGM * nN, gid = wgid / nig, fm = gid * WGM, gsz = (nM - fm) < WGM ? (nM - fm) : WGM;
        pm = fm + ((wgid % nig) % gsz); pn = (wgid % nig) / gsz; return true;
    }
};

typedef int i32x4 __attribute__((ext_vector_type(4)));
template <bool I8> __device__ __forceinline__ f32x4 mma_sel(bf16x8 a, bf16x8 b, f32x4 c) {
    if constexpr (I8) return __builtin_bit_cast(f32x4, __builtin_amdgcn_mfma_i32_16x16x64_i8(__builtin_bit_cast(i32x4, a), __builtin_bit_cast(i32x4, b), __builtin_bit_cast(i32x4, c), 0, 0, 0));
    else return __builtin_amdgcn_mfma_f32_16x16x32_bf16(a, b, c, 0, 0, 0);
}
__device__ __forceinline__ unsigned cvt_pk_bf16(float lo, float hi) { unsigned r; asm volatile("v_cvt_pk_bf16_f32 %0, %1, %2" : "=v"(r) : "v"(lo), "v"(hi)); return r; }

template <class Epi, class Sched, bool GATHER, bool ALIGN_EPI, bool SP2, bool ROWS_LDS = false>
__device__ __forceinline__ void gemm_phase(PG8_LAS unsigned char* lds, const unsigned lda, const unsigned ldb, const Sched& S, const Epi& E) {
    int tid_ = threadIdx.x; asm volatile("" : "+v"(tid_));
    const int tid = tid_, wid = __builtin_amdgcn_readfirstlane(tid >> 6), lane = tid & 63, wr = wid >> 2, wc = wid & 3, fr = lane & 15, fq = lane >> 4;
    unsigned voffA[2], voffB[2]; int RA[2];
#pragma unroll
    for (int i = 0; i < 2; ++i) { int R, C; stage_rc(tid * 16 + i * 8192, R, C); const int Rb = Epi::PERM ? ((Epi::PAIR64 ? 64 * (R >> 5) : (R & ~31)) + perm32(R & 31)) : R;
        RA[i] = R; voffA[i] = GATHER ? (unsigned)(C * 2) : (unsigned)R * lda + (unsigned)(C * 2); voffB[i] = (unsigned)Rb * ldb + (unsigned)(C * 2); }
    const size_t kstep = (size_t)(BK * 2);
    const size_t hstepA = (size_t)HALF * lda, hstepB = (size_t)(Epi::PAIR64 ? 32 : HALF) * ldb;
    const unsigned ldsw = (unsigned)wid * 1024u;
    const int aoff = lds_byte(wr * 64 + fr, fq * 8), boff = lds_byte(wc * 32 + fr, fq * 8);
    unsigned gcur[2][2], gnxt[2][2];
#define PG8_SA(b, h) (((b) * 2 + (h)) * HTB)
#define PG8_SB(b, h) ((4 + (b) * 2 + (h)) * HTB)
#define PG8_STAGE_B(bufoff, gbase, h) do { _Pragma("unroll") for (int _i = 0; _i < 2; ++_i) \
        __builtin_amdgcn_global_load_lds((const unsigned*)((const char*)(gbase) + (size_t)(h) * hstepB + voffB[_i]), (PG8_LAS unsigned*)(lds + (bufoff) + ldsw + _i * 8192), 16, 0, 0); } while (0)
#define PG8_STAGE_A(bufoff, gbase, h) do { _Pragma("unroll") for (int _i = 0; _i < 2; ++_i) { \
        const char* _p = GATHER ? ((const char*)(gbase) + gcur[_i][h]) : ((const char*)(gbase) + (size_t)(h) * hstepA + voffA[_i]); \
        __builtin_amdgcn_global_load_lds((const unsigned*)_p, (PG8_LAS unsigned*)(lds + (bufoff) + ldsw + _i * 8192), 16, 0, 0); } } while (0)
#define PG8_GATHER_OFFS(dst, U) do { _Pragma("unroll") for (int _i = 0; _i < 2; ++_i) _Pragma("unroll") for (int _h = 0; _h < 2; ++_h) { \
        const int _r = RA[_i] + 128 * _h; int _idx; \
        if ((U).rows) { _idx = (U).rows[_r < (U).nvalid ? _r : 0] >> (U).shift; } else { _idx = (U).rowbase + _r; } \
        dst[_i][_h] = (unsigned)_idx * lda + voffA[_i]; } } while (0)
#define PG8_LDA(dst, b, h) do { _Pragma("unroll") for (int m = 0; m < 4; ++m) _Pragma("unroll") for (int k = 0; k < 2; ++k) dst[m][k] = *(const PG8_LAS bf16x8*)(lds + PG8_SA(b, h) + aoff + m * 2048 + k * 1024); } while (0)
#define PG8_LDB(dst, b, h) do { _Pragma("unroll") for (int n = 0; n < 2; ++n) _Pragma("unroll") for (int k = 0; k < 2; ++k) dst[n][k] = *(const PG8_LAS bf16x8*)(lds + PG8_SB(b, h) + boff + n * 2048 + k * 1024); } while (0)
#define PG8_MMA(ai, bj, At, Bt) do { __builtin_amdgcn_s_setprio(1); _Pragma("unroll") for (int m = 0; m < 4; ++m) _Pragma("unroll") for (int n = 0; n < 2; ++n) _Pragma("unroll") for (int k = 0; k < 2; ++k) \
        acc[ai][bj][m][n] = mma_sel<Epi::I8>(Bt[n][k], At[m][k], acc[ai][bj][m][n]); __builtin_amdgcn_s_setprio(0); } while (0)
#define PG8_WAIT_V(n) asm volatile("s_waitcnt vmcnt(" #n ")" ::: "memory")
#define PG8_WAIT_L(n) asm volatile("s_waitcnt lgkmcnt(" #n ")" ::: "memory")
#define PG8_BAR __builtin_amdgcn_s_barrier()
#define PG8_SCHED __builtin_amdgcn_sched_barrier(0)
    Unit cur, nxt; int ui = 0;
    if (!S.next(0, cur)) return;
    PG8_LAS int* rowbuf = (PG8_LAS int*)(lds + 131072); int nextrow = 0;
    if constexpr (ROWS_LDS) { if (tid < 256) rowbuf[tid] = cur.rows[tid < cur.nvalid ? tid : 0]; }
    f32x4 acc[2][2][4][2];
#pragma unroll
    for (int a = 0; a < 2; ++a)
#pragma unroll
        for (int b = 0; b < 2; ++b)
#pragma unroll
            for (int m = 0; m < 4; ++m)
#pragma unroll
                for (int n = 0; n < 2; ++n) acc[a][b][m][n] = (f32x4){0.f, 0.f, 0.f, 0.f};
    bf16x8 At[4][2], B0[2][2], B1[2][2];
    const char* cA = cur.A; const char* cB = cur.B;
    if constexpr (GATHER) { PG8_GATHER_OFFS(gcur, cur); }
    if constexpr (SP2) {
        PG8_STAGE_B(PG8_SB(0, 0), cB, 0); PG8_STAGE_B(PG8_SB(0, 1), cB, 1); PG8_STAGE_A(PG8_SA(0, 0), cA, 0); PG8_STAGE_A(PG8_SA(0, 1), cA, 1);
        if (wr == 1) PG8_BAR;
        PG8_WAIT_V(2); PG8_BAR;
        PG8_STAGE_B(PG8_SB(1, 0), cB + kstep, 0); PG8_STAGE_A(PG8_SA(1, 0), cA + kstep, 0); PG8_STAGE_B(PG8_SB(1, 1), cB + kstep, 1);
        PG8_WAIT_V(6); PG8_BAR;
    } else {
        PG8_STAGE_B(PG8_SB(0, 0), cB, 0); PG8_STAGE_A(PG8_SA(0, 0), cA, 0); PG8_STAGE_B(PG8_SB(0, 1), cB, 1); PG8_STAGE_A(PG8_SA(0, 1), cA, 1);
        if (wr == 1) PG8_BAR;
        PG8_WAIT_V(4); PG8_BAR;
        PG8_STAGE_B(PG8_SB(1, 0), cB + kstep, 0); PG8_STAGE_A(PG8_SA(1, 0), cA + kstep, 0); PG8_STAGE_B(PG8_SB(1, 1), cB + kstep, 1);
        PG8_WAIT_V(6); PG8_BAR;
    }
    for (;;) {
        const bool has_next = S.next(ui + 1, nxt);
        if constexpr (ROWS_LDS) { if (has_next && tid < 256) nextrow = nxt.rows[tid < nxt.nvalid ? tid : 0]; }
        const char* nA = has_next ? nxt.A : cA; const char* nB = has_next ? nxt.B : cB;
        if constexpr (GATHER) {
            if (has_next) { PG8_GATHER_OFFS(gnxt, nxt); }
            else {
#pragma unroll
                for (int i = 0; i < 2; ++i)
#pragma unroll
                    for (int h = 0; h < 2; ++h) gnxt[i][h] = gcur[i][h];
            }
        }
        int nt = cur.nt; asm volatile("" : "+s"(nt));
        for (int t = 0; t < nt; t += 2) {
            const bool last = (t == nt - 2);
            const char* a1 = cA + (size_t)(t + 1) * kstep;
            const char* a2 = last ? nA : cA + (size_t)(t + 2) * kstep; const char* b2 = last ? nB : cB + (size_t)(t + 2) * kstep;
            const char* a3 = a2 + kstep; const char* b3 = b2 + kstep;
            if constexpr (SP2) {
            PG8_LDB(B0, 0, 0); PG8_LDB(B1, 0, 1); PG8_SCHED; PG8_LDA(At, 0, 0); PG8_STAGE_A(PG8_SA(1, 1), a1, 1);
            if constexpr (GATHER) { if (last) {
#pragma unroll
                for (int i = 0; i < 2; ++i)
#pragma unroll
                    for (int h = 0; h < 2; ++h) gcur[i][h] = gnxt[i][h]; } }
            PG8_WAIT_V(8); PG8_WAIT_L(0); PG8_BAR; PG8_MMA(0, 0, At, B0); PG8_MMA(0, 1, At, B1); PG8_BAR; PG8_SCHED;
            PG8_LDA(At, 0, 1); PG8_STAGE_B(PG8_SB(0, 0), b2, 0); PG8_STAGE_B(PG8_SB(0, 1), b2, 1); PG8_STAGE_A(PG8_SA(0, 0), a2, 0);
            PG8_WAIT_V(8); PG8_WAIT_L(0); PG8_BAR; PG8_MMA(1, 0, At, B0); PG8_MMA(1, 1, At, B1); PG8_BAR; PG8_SCHED;
            PG8_LDB(B0, 1, 0); PG8_LDB(B1, 1, 1); PG8_SCHED; PG8_LDA(At, 1, 0); PG8_STAGE_A(PG8_SA(0, 1), a2, 1);
            PG8_WAIT_V(8); PG8_WAIT_L(0); PG8_BAR; PG8_MMA(0, 0, At, B0); PG8_MMA(0, 1, At, B1); PG8_BAR; PG8_SCHED;
            PG8_LDA(At, 1, 1); PG8_STAGE_B(PG8_SB(1, 0), b3, 0); PG8_STAGE_B(PG8_SB(1, 1), b3, 1); PG8_STAGE_A(PG8_SA(1, 0), a3, 0);
            PG8_WAIT_V(8); PG8_WAIT_L(0); PG8_BAR; PG8_MMA(1, 0, At, B0); PG8_MMA(1, 1, At, B1); PG8_BAR; PG8_SCHED;
            } else {
            PG8_LDB(B0, 0, 0); PG8_SCHED; PG8_LDA(At, 0, 0); PG8_STAGE_A(PG8_SA(1, 1), a1, 1);
            if constexpr (GATHER) { if (last) {
#pragma unroll
                for (int i = 0; i < 2; ++i)
#pragma unroll
                    for (int h = 0; h < 2; ++h) gcur[i][h] = gnxt[i][h]; } }
            PG8_WAIT_L(8); PG8_BAR; PG8_WAIT_L(0); PG8_MMA(0, 0, At, B0); PG8_BAR; PG8_SCHED;
            PG8_LDB(B1, 0, 1); PG8_STAGE_B(PG8_SB(0, 0), b2, 0);
            PG8_BAR; PG8_WAIT_L(0); PG8_MMA(0, 1, At, B1); PG8_BAR;
            PG8_LDA(At, 0, 1); PG8_STAGE_A(PG8_SA(0, 0), a2, 0);
            PG8_BAR; PG8_WAIT_L(0); PG8_MMA(1, 0, At, B0); PG8_BAR; PG8_SCHED;
            PG8_STAGE_B(PG8_SB(0, 1), b2, 1);
            PG8_WAIT_V(6); PG8_BAR; PG8_MMA(1, 1, At, B1); PG8_BAR;
            PG8_LDB(B0, 1, 0); PG8_SCHED; PG8_LDA(At, 1, 0); PG8_STAGE_A(PG8_SA(0, 1), a2, 1);
            PG8_WAIT_L(8); PG8_BAR; PG8_WAIT_L(0); PG8_MMA(0, 0, At, B0); PG8_BAR; PG8_SCHED;
            PG8_LDB(B1, 1, 1); PG8_STAGE_B(PG8_SB(1, 0), b3, 0);
            PG8_BAR; PG8_WAIT_L(0); PG8_MMA(0, 1, At, B1); PG8_BAR;
            PG8_LDA(At, 1, 1); PG8_STAGE_A(PG8_SA(1, 0), a3, 0);
            PG8_BAR; PG8_WAIT_L(0); PG8_MMA(1, 0, At, B0); PG8_BAR; PG8_SCHED;
            PG8_STAGE_B(PG8_SB(1, 1), b3, 1);
            PG8_WAIT_V(6); PG8_BAR; PG8_MMA(1, 1, At, B1); PG8_BAR;
            }
        }
        if constexpr (ROWS_LDS) { if (has_next && tid < 256) rowbuf[((ui + 1) & 1) * 256 + tid] = nextrow; }
        if (cur.epi) {
            if constexpr (ALIGN_EPI) { if (wr == 0) PG8_BAR; }
            E(acc, cur, wr, wc, fr, fq, (const PG8_LAS int*)(rowbuf + (ui & 1) * 256));
#pragma unroll
            for (int a = 0; a < 2; ++a)
#pragma unroll
                for (int b = 0; b < 2; ++b)
#pragma unroll
                    for (int m = 0; m < 4; ++m)
#pragma unroll
                        for (int n = 0; n < 2; ++n) acc[a][b][m][n] = (f32x4){0.f, 0.f, 0.f, 0.f};
        }
        if (!has_next) break;
        const int did_epi = cur.epi;
        cur = nxt; cA = nA; cB = nB; ++ui;
        if constexpr (ALIGN_EPI) { if (did_epi && wr == 1) PG8_BAR; }
    }
    PG8_WAIT_V(0);
    if constexpr (!ALIGN_EPI) { if (wr == 0) PG8_BAR; } else { if (!cur.epi && wr == 0) PG8_BAR; }
    PG8_BAR;
#undef PG8_SA
#undef PG8_SB
#undef PG8_STAGE_A
#undef PG8_STAGE_B
#undef PG8_GATHER_OFFS
#undef PG8_LDA
#undef PG8_LDB
#undef PG8_MMA
#undef PG8_WAIT_V
#undef PG8_WAIT_L
#undef PG8_BAR
#undef PG8_SCHED
}
}
#define XB_TMO      128
#define XB_XCNT(j)  (256  + 64 * (j))
#define XB_XSUB(j)  (1280 + 64 * (j))
#define XB_XGEN(j)  (2304 + 64 * (j))
#define XB_TOP      3328
#define XB_TOPGEN   3392
#define XCD_BAR_WORDS 3456
#define XB_SPIN_CAP (1u << 18)

__device__ __forceinline__ unsigned xb_ld(unsigned* p)              { return __hip_atomic_load(p, __ATOMIC_RELAXED, __HIP_MEMORY_SCOPE_AGENT); }
__device__ __forceinline__ unsigned xb_add(unsigned* p, unsigned v) { return __hip_atomic_fetch_add(p, v, __ATOMIC_RELAXED, __HIP_MEMORY_SCOPE_AGENT); }
__device__ __forceinline__ unsigned xb_xcc_id() { return (unsigned)__builtin_amdgcn_s_getreg((3 << 11) | 20) & 0xFu; }
#define XB_SPIN(cond, bar) do { unsigned _sp = 0; while (cond) { __builtin_amdgcn_s_sleep(1); \
    if ((++_sp & 255u) == 0u) { if (xb_ld(&(bar)[XB_TMO])) break; if (_sp > XB_SPIN_CAP) { atomicAdd(&(bar)[XB_TMO], 1u); break; } } } } while (0)

struct XcdBarrier {
    unsigned* bar; unsigned x;
    volatile LAS unsigned* st;
};

__device__ __forceinline__ XcdBarrier xcd_barrier_post(unsigned* bar, volatile LAS unsigned* st) {
    XcdBarrier b; b.bar = bar; b.x = xb_xcc_id(); b.st = st;
    if (threadIdx.x == 0) (void)xb_add(&bar[XB_XCNT(b.x)], 1u);
    return b;
}
__device__ __forceinline__ void xcd_barrier_complete(unsigned* bar, unsigned x, unsigned& nloc, unsigned& nx) {
    const unsigned G = gridDim.x * gridDim.y * gridDim.z;
    unsigned sum, cnt, mine, sp = 0u;
    for (;;) {
        sum = 0u; cnt = 0u; mine = 0u;
#pragma unroll
        for (unsigned j = 0; j < 16; ++j) { const unsigned c = xb_ld(&bar[XB_XCNT(j)]); sum += c; cnt += (c > 0u) ? 1u : 0u; mine = (j == x) ? c : mine; }
        if (sum == G) break;
        __builtin_amdgcn_s_sleep(1);
        if ((++sp & 255u) == 0u) { if (xb_ld(&bar[XB_TMO])) break; if (sp > XB_SPIN_CAP) { atomicAdd(&bar[XB_TMO], 1u); break; } }
    }
    nloc = mine > 0u ? mine : 1u; nx = cnt > 0u ? cnt : 1u;
}

__device__ __forceinline__ void xcd_barrier(const XcdBarrier& b) {
    asm volatile("s_waitcnt vmcnt(0)" ::: "memory");
    __syncthreads();
    if (threadIdx.x == 0) {
        unsigned* bar = b.bar;
        __builtin_amdgcn_s_waitcnt(0);
        unsigned nloc = b.st[0], nx = b.st[1];
        if (nloc == 0u) { xcd_barrier_complete(bar, b.x, nloc, nx); b.st[0] = nloc; b.st[1] = nx; }
        const unsigned old = xb_add(&bar[XB_XSUB(b.x)], 1u);
        const unsigned gen = old / nloc;
        if (old + 1u == (gen + 1u) * nloc) {
            __builtin_amdgcn_fence(__ATOMIC_RELEASE, "agent");
            asm volatile("s_waitcnt vmcnt(0)" ::: "memory");
            const unsigned og = xb_add(&bar[XB_TOP], 1u);
            const unsigned tg = og / nx;
            if (og + 1u == (tg + 1u) * nx) xb_add(&bar[XB_TOPGEN], 1u);
            else XB_SPIN(xb_ld(&bar[XB_TOPGEN]) == tg, bar);
            __builtin_amdgcn_fence(__ATOMIC_ACQUIRE, "agent");
            xb_add(&bar[XB_XGEN(b.x)], 1u);
            asm volatile("s_waitcnt vmcnt(0)" ::: "memory");
        } else {
            XB_SPIN(xb_ld(&bar[XB_XGEN(b.x)]) == gen, bar);
            __builtin_amdgcn_fence(__ATOMIC_ACQUIRE, "agent");
            asm volatile("s_waitcnt vmcnt(0)" ::: "memory");
        }
    }
    __syncthreads();
}

struct Args { const void* in[31]; float* out; unsigned char* ws; int ph_lo, ph_hi; };
enum { I_X = 0, I_POS, I_LNIN_G, I_LNIN_B, I_WIN, I_CPOSK, I_CPOSV, I_CW1K, I_CW2K, I_CW1V, I_CW2V, I_LBLOG, I_HGNG, I_POOLW, I_POOLS, I_WUA, I_WUH, I_WUP, I_WO,
       I_LN1G, I_LN1B, I_RW, I_RB, I_W1, I_W3, I_W2, I_WS1, I_WS3, I_WS2, I_LN2G, I_LN2B };

__device__ __forceinline__ const void* ain_(const Args& A, int i) { asm volatile("" : "+s"(i)); return (const void*)(const GAS void*)A.in[i]; }

struct Frame {
    LAS unsigned char* lds;
    volatile LAS unsigned* MISC;
    gu32* ctl;
    unsigned char* ws;
    int tid, lane, wave, vcu, G, gw, NGW;
};

__device__ __forceinline__ int p0_rowmap(int n, int mode, int rowoff) {
    if (mode == 1) return n < 3584 ? n : (n < 3632 ? C_AG + (n - 3584) : n - 48);
    if (mode == 2) return (n >> 7) * 256 + (n & 127) + rowoff;
    return n + rowoff;
}
__device__ __forceinline__ void p0_item(const float* W, int N, bf16* dst, int ldd, int coff, int mode, int rowoff, LAS float* scr, int kb, int nb, int lane, bool dostore = true) {
    const int k0 = 64 * kb, n0 = 64 * nb;
    const int r4 = lane >> 4, c4 = (lane & 15) * 4;
    const bool nok = n0 + c4 < N;
    f32x4 v[16];
#pragma unroll
    for (int i = 0; i < 16; ++i) v[i] = nok ? __builtin_nontemporal_load((const f32x4*)(W + (size_t)(k0 + 4 * i + r4) * N + n0 + c4)) : (f32x4){0.f, 0.f, 0.f, 0.f};
#pragma unroll
    for (int i = 0; i < 16; ++i) { LAS float* d = scr + (4 * i + r4) * 65 + c4; d[0] = v[i].x; d[1] = v[i].y; d[2] = v[i].z; d[3] = v[i].w; }
    LDS_WAIT(); asm volatile("" ::: "memory");
    const int kc = lane & 7;
#pragma unroll
    for (int j = 0; j < 8; ++j) { const int n = (lane >> 3) + 8 * j; const LAS float* sp = scr + (8 * kc) * 65 + n;
        u32x4 o; o.x = pk2(sp[0 * 65], sp[1 * 65]); o.y = pk2(sp[2 * 65], sp[3 * 65]); o.z = pk2(sp[4 * 65], sp[5 * 65]); o.w = pk2(sp[6 * 65], sp[7 * 65]);
        if (n0 + n < N && dostore) __builtin_nontemporal_store(o, (u32x4*)(dst + (size_t)p0_rowmap(n0 + n, mode, rowoff) * ldd + coff + k0 + 8 * kc)); }
    LDS_WAIT(); asm volatile("" ::: "memory");
}
__device__ __forceinline__ void p0_tile(const float* W, int K, int N, bf16* dst, int ldd, int coff, int mode, int rowoff, LAS unsigned* T, int kb, int nb, int wave, int lane, bool dostore) {
    const int k0 = 256 * kb, n0 = 256 * nb;
    const bool nok = n0 + 4 * lane < N;
#pragma unroll
    for (int half = 0; half < 2; ++half) {
        f32x4 v[16];
        const int kr = k0 + 32 * wave + 16 * half;
#pragma unroll
        for (int i = 0; i < 16; ++i) v[i] = (nok && kr + i < K && dostore) ? __builtin_nontemporal_load((const f32x4*)(W + (size_t)(kr + i) * N + n0 + 4 * lane)) : (f32x4){0.f, 0.f, 0.f, 0.f};
#pragma unroll
        for (int i = 0; i < 16; i += 2) { const int w = (32 * wave + 16 * half + i) >> 1;
#pragma unroll
            for (int e = 0; e < 4; ++e) T[(4 * lane + e) * 129 + w] = pk2(v[i][e], v[i + 1][e]); }
    }
    __syncthreads();
    const int rs = lane >> 5, c = lane & 31;
#pragma unroll 4
    for (int j = 0; j < 16; ++j) { const int n = 32 * wave + 2 * j + rs; const LAS unsigned* sp = T + n * 129 + 4 * c;
        const u32x4 o = {sp[0], sp[1], sp[2], sp[3]};
        if (n0 + n < N && k0 + 8 * c < K) __builtin_nontemporal_store(o, (u32x4*)(dst + (dostore ? (size_t)0 : (size_t)454 * MiB) + (size_t)p0_rowmap(n0 + n, mode, rowoff) * ldd + coff + k0 + 8 * c)); }
    __syncthreads();
}
__device__ __forceinline__ void ln_finish(f32x4 (&v)[16], const float* g, const float* b, float* orow, bf16* brow, int lane) {
    float s = 0.f;
#pragma unroll
    for (int j = 0; j < 16; ++j) s += (v[j].x + v[j].y) + (v[j].z + v[j].w);
    const float mean = wave_sum(s) * (1.f / DM); float s2 = 0.f;
#pragma unroll
    for (int j = 0; j < 16; ++j) { v[j] = v[j] - mean; s2 += (v[j].x * v[j].x + v[j].y * v[j].y) + (v[j].z * v[j].z + v[j].w * v[j].w); }
    const float rstd = 1.f / sqrtf(wave_sum(s2) * (1.f / DM) + LN_EPS);
#pragma unroll
    for (int j = 0; j < 16; ++j) { const int c = 4 * (lane + 64 * j);
        const f32x4 gg = *(const f32x4*)(g + c), bb = *(const f32x4*)(b + c);
        const f32x4 o = v[j] * rstd * gg + bb;
        if (orow) *(f32x4*)(orow + c) = o;
        u32x2 w; w.x = pk2(o.x, o.y); w.y = pk2(o.z, o.w); *(u32x2*)(brow + c) = w; }
}

__device__ __forceinline__ void p0_phase(Frame& F, const Args& A, int l, bool dostore = true) {
    LAS float* scr = (LAS float*)(F.lds + F.wave * 17408);
    unsigned char* ws = F.ws;
    const int gw = F.gw, NGW = F.NGW, lane = F.lane;
    if (gw < 256) {
        const int kv = gw >> 7, n = gw & 127;
        const float* pos = (const float*)ain_(A, kv ? I_CPOSV : I_CPOSK) + (size_t)l * 4096;
        const float* w1 = (const float*)ain_(A, kv ? I_CW1V : I_CW1K) + (size_t)l * 4096 * 128;
        float s = 0.f;
#pragma unroll 16
        for (int i = 0; i < 64; ++i) { const int k = lane + 64 * i; s += pos[k] * w1[(size_t)k * 128 + n]; }
        s = wave_sum(s);
        if (lane == 0) ((float*)(ws + WS_SMALL + SM_BIAS1))[kv * 128 + n] = s;
    }
    {
        u32x4 z = {0u, 0u, 0u, 0u};
        u32x4* p1 = (u32x4*)(ws + WS_WIN + (size_t)NIN_SRC * WLD * 2); const int n1 = (PLD - NIN_SRC) * WLD * 2 / 16;
        for (int i = gw * 64 + lane; i < n1; i += NGW * 64) p1[i] = z;
        u32x4* p2 = (u32x4*)(ws + WS_ROUTER + (size_t)64 * WLD * 2); const int n2 = 192 * WLD * 2 / 16;
        for (int i = gw * 64 + lane; i < n2; i += NGW * 64) p2[i] = z;
    }
    {
        LAS unsigned* T = (LAS unsigned*)F.lds;
        const int wave = F.wave, bidv = F.vcu, Gv = F.G;
        int rot = 0;
#define P0_JOB(NJ, ...) do { const int g0_ = (bidv + rot) % Gv; for (int r = g0_; r < (NJ); r += Gv) { __VA_ARGS__; } rot += (NJ); } while (0)
#define P0_T(W, K, N, DST, LDD, COFF, MODE, ROWOFF, KB, NB) p0_tile((W), (K), (N), (DST), (LDD), (COFF), (MODE), (ROWOFF), T, (KB), (NB), wave, lane, dostore)
        P0_JOB(16 * 83, P0_T((const float*)ain_(A, I_WIN) + (size_t)l * 4096 * NIN_SRC, 4096, NIN_SRC, (bf16*)(ws + WS_WIN), WLD, 0, 1, 0, r & 15, r >> 4));
        P0_JOB(8 * 16, P0_T((const float*)ain_(A, I_WUA) + (size_t)l * 2048 * 4096, 2048, 4096, (bf16*)(ws + WS_WUP), WLD, 0, 0, 0, r & 7, r >> 3));
        P0_JOB(4 * 16, P0_T((const float*)ain_(A, I_WUH) + (size_t)l * 1024 * 4096, 1024, 4096, (bf16*)(ws + WS_WUP), WLD, 2048, 0, 0, r & 3, r >> 2));
        P0_JOB(4 * 16, P0_T((const float*)ain_(A, I_WUP) + (size_t)l * 1024 * 4096, 1024, 4096, (bf16*)(ws + WS_WUP), WLD, 3072, 0, 0, r & 3, r >> 2));
        P0_JOB(16 * 16, P0_T((const float*)ain_(A, I_WO) + (size_t)l * 4096 * 4096, 4096, 4096, (bf16*)(ws + WS_WO), WLD, 0, 0, 0, r & 15, r >> 4));
        P0_JOB(64 * 16, const int e = r >> 4; P0_T((const float*)ain_(A, I_W1) + ((size_t)l * NEXP + e) * 4096 * 128, 4096, 128, (bf16*)(ws + WS_W13) + (size_t)e * 256 * WLD, WLD, 0, 0, 0, r & 15, 0));
        P0_JOB(64 * 16, const int e = r >> 4; P0_T((const float*)ain_(A, I_W3) + ((size_t)l * NEXP + e) * 4096 * 128, 4096, 128, (bf16*)(ws + WS_W13) + (size_t)e * 256 * WLD, WLD, 0, 0, 128, r & 15, 0));
        P0_JOB(64 * 16, const int e = r >> 4; P0_T((const float*)ain_(A, I_W2) + ((size_t)l * NEXP + e) * 128 * 4096, 128, 4096, (bf16*)(ws + WS_W2) + (size_t)e * 4096 * 128, 128, 0, 0, 0, 0, r & 15));
        P0_JOB(16, P0_T((const float*)ain_(A, I_WS1) + (size_t)l * 4096 * 256, 4096, 256, (bf16*)(ws + WS_WS13), WLD, 0, 2, 0, r, 0));
        P0_JOB(16, P0_T((const float*)ain_(A, I_WS3) + (size_t)l * 4096 * 256, 4096, 256, (bf16*)(ws + WS_WS13), WLD, 0, 2, 128, r, 0));
        P0_JOB(16, P0_T((const float*)ain_(A, I_WS2) + (size_t)l * 256 * 4096, 256, 4096, (bf16*)(ws + WS_WS2), 256, 0, 0, 0, 0, r));
        P0_JOB(16, P0_T((const float*)ain_(A, I_CW1K) + (size_t)l * 4096 * 128, 4096, 128, (bf16*)(ws + WS_CW1), WLD, 0, 0, 0, r, 0));
        P0_JOB(16, P0_T((const float*)ain_(A, I_CW1V) + (size_t)l * 4096 * 128, 4096, 128, (bf16*)(ws + WS_CW1) + 128 * WLD, WLD, 0, 0, 0, r, 0));
        P0_JOB(1, P0_T((const float*)ain_(A, I_CW2K) + (size_t)l * 128 * 128, 128, 128, (bf16*)(ws + WS_SMALL + SM_CW2), 128, 0, 0, 0, 0, 0));
        P0_JOB(1, P0_T((const float*)ain_(A, I_CW2V) + (size_t)l * 128 * 128, 128, 128, (bf16*)(ws + WS_SMALL + SM_CW2) + 128 * 128, 128, 0, 0, 0, 0, 0));
        P0_JOB(4, P0_T((const float*)ain_(A, I_POOLW) + ((size_t)l * 4 + r) * 256 * 256, 256, 256, (bf16*)(ws + WS_SMALL + SM_POOL) + (size_t)r * 256 * 256, 256, 0, 0, 0, 0, 0));
        P0_JOB(16, P0_T((const float*)ain_(A, I_RW) + (size_t)l * 4096 * 64, 4096, 64, (bf16*)(ws + WS_ROUTER), WLD, 0, 0, 0, r, 0));
#undef P0_T
#undef P0_JOB
    }
    if (l == 0) {
        const int* pos = (const int*)ain_(A, I_POS);
        float* rc = (float*)(ws + WS_ROPE); float* rs = rc + NTOK * 16;
        for (int i = gw * 64 + lane; i < NTOK * 16; i += NGW * 64) {
            const int m = i >> 4, k = i & 15;
            double invturn = 0.15915494309189535;
            for (int j = 0; j < k; ++j) invturn *= 0.44036660267178046;
            double tr = (double)pos[m] * invturn; tr -= (double)(long long)tr;
            const float fr = (float)tr;
            rc[i] = __builtin_amdgcn_cosf(fr); rs[i] = __builtin_amdgcn_sinf(fr);
        }
    }
}
__device__ __forceinline__ f32x4 mma16(bf16x8 a, bf16x8 b, f32x4 c) { return __builtin_amdgcn_mfma_f32_16x16x32_bf16(a, b, c, 0, 0, 0); }
__device__ __forceinline__ bf16x8 pack_p(f32x4 a, f32x4 b) {
    u32x4 w = {pg8::cvt_pk_bf16(a[0], a[1]), pg8::cvt_pk_bf16(a[2], a[3]), pg8::cvt_pk_bf16(b[0], b[1]), pg8::cvt_pk_bf16(b[2], b[3])};
    return __builtin_bit_cast(bf16x8, w);
}
__device__ __forceinline__ bf16x8 join8(u32x2 lo, u32x2 hi) { u32x4 w = {lo.x, lo.y, hi.x, hi.y}; return __builtin_bit_cast(bf16x8, w); }
__device__ __forceinline__ float max4(f32x4 v) { return fmaxf(fmaxf(v[0], v[1]), fmaxf(v[2], v[3])); }
__device__ __forceinline__ float sum4(f32x4 v) { return (v[0] + v[1]) + (v[2] + v[3]); }
__device__ __forceinline__ float swap16_other(float v, float& own) { auto rr = __builtin_amdgcn_permlane16_swap(__float_as_uint(v), __float_as_uint(v), false, false); own = __uint_as_float(rr[0]); return __uint_as_float(rr[1]); }
__device__ __forceinline__ float swap32_other(float v, float& own) { auto rr = __builtin_amdgcn_permlane32_swap(__float_as_uint(v), __float_as_uint(v), false, false); own = __uint_as_float(rr[0]); return __uint_as_float(rr[1]); }
__device__ __forceinline__ float xor_max_q(float v) { float a, b; b = swap16_other(v, a); v = fmaxf(a, b); b = swap32_other(v, a); return fmaxf(a, b); }
__device__ __forceinline__ float xor_sum_q(float v) { float a, b; b = swap16_other(v, a); v = a + b; b = swap32_other(v, a); return a + b; }
#define NEG_INF (-__builtin_inff())
__device__ __forceinline__ int kt_off(int key, int dim) { return (key >> 4) * 2048 + (dim >> 5) * 512 + (key & 15) * 32 + (dim & 31); }
__device__ __forceinline__ int vb_pos(int keyl) { return 8 * ((keyl & 15) >> 2) + 4 * ((keyl >> 4) & 1) + (keyl & 3); }
__device__ __forceinline__ int rank64(float val, int lane, LAS float* scr) {
    scr[lane] = val;
    LDS_WAIT(); asm volatile("" ::: "memory");
    int rank = 0;
#pragma unroll
    for (int j4 = 0; j4 < 16; ++j4) { const f32x4 v = *(const LAS f32x4*)(scr + 4 * j4);
#pragma unroll
        for (int e = 0; e < 4; ++e) { const int j = 4 * j4 + e; rank += (v[e] > val || (v[e] == val && j < lane)) ? 1 : 0; } }
    LDS_WAIT(); asm volatile("" ::: "memory");
    return rank;
}

__device__ __forceinline__ void hgrn_unit(Frame& F, const Args& A, int l, int u) {
    const int b = u >> 5, h = (u >> 2) & 7, vs = u & 3;
    LAS float* QF = (LAS float*)(F.lds);
    LAS float* FF = (LAS float*)(F.lds + 32768);
    LAS float* VV = (LAS float*)(F.lds + 65536);
    LAS float* PART = (LAS float*)(F.lds + 73728);
    LAS float* LB = (LAS float*)(F.lds + 106496);
    const bf16* proj = (const bf16*)(F.ws + WS_PROJ);
    float* ohg = (float*)(F.ws + WS_OHG);
    const int tid = F.tid, lane = F.lane, wave = F.wave;
    if (tid < 128) {
        float lb = 0.f;
        if (l == 1) { const float* lg = (const float*)ain_(A, I_LBLOG); lb = sigmoidf_(lg[1024 + h * 128 + tid] - lg[h * 128 + tid]); }
        LB[tid] = lb;
    }
    __syncthreads();
    const int tt = tid >> 4, c16 = tid & 15;
    const int tv = tid >> 2, pv = tid & 3;
    float lb8[8];
#pragma unroll
    for (int e = 0; e < 8; ++e) lb8[e] = LB[8 * c16 + e];
    const size_t rowb = (size_t)b * SEQ;
    u32x4 rq, rf, rv = {0u, 0u, 0u, 0u};
#define HG_LOAD(c) do { const bf16* pr = proj + (rowb + (c) * 32 + tt) * PLD; rq = *(const u32x4*)(pr + C_HQ + h * 128 + 8 * c16); rf = *(const u32x4*)(pr + C_HF + h * 128 + 8 * c16); \
        if (tid < 128) rv = *(const u32x4*)(proj + (rowb + (c) * 32 + tv) * PLD + C_HI + h * 128 + vs * 32 + 8 * pv); } while (0)
#define HG_STORE(buf) do { LAS float* qd = QF + (buf) * 4096 + tt * 128 + 8 * c16; LAS float* fd = FF + (buf) * 4096 + tt * 128 + 8 * c16; \
        const unsigned qw[4] = {rq.x, rq.y, rq.z, rq.w}, fw[4] = {rf.x, rf.y, rf.z, rf.w}; \
        _Pragma("unroll") for (int e = 0; e < 4; ++e) { qd[2 * e] = bflo(qw[e]); qd[2 * e + 1] = bfhi(qw[e]); \
            fd[2 * e] = lb8[2 * e] + (1.f - lb8[2 * e]) * sigmoidf_(bflo(fw[e])); fd[2 * e + 1] = lb8[2 * e + 1] + (1.f - lb8[2 * e + 1]) * sigmoidf_(bfhi(fw[e])); } \
        if (tid < 128) { LAS float* vd = VV + (buf) * 1024 + tv * 32 + 8 * pv; const unsigned vw[4] = {rv.x, rv.y, rv.z, rv.w}; \
            _Pragma("unroll") for (int e = 0; e < 4; ++e) { vd[2 * e] = bflo(vw[e]); vd[2 * e + 1] = bfhi(vw[e]); } } } while (0)
    HG_LOAD(0); HG_STORE(0);
    const int kg = tid >> 5, v = tid & 31;
    float S[8];
#pragma unroll
    for (int e = 0; e < 8; ++e) S[e] = 0.f;
    for (int c = 0; c < 64; ++c) {
        const int buf = c & 1;
        asm volatile("s_waitcnt lgkmcnt(0)\n\ts_barrier" ::: "memory");
        if (c + 1 < 64) HG_LOAD(c + 1);
        const LAS float* fp = FF + buf * 4096 + 8 * kg; const LAS float* qp = QF + buf * 4096 + 8 * kg; const LAS float* vp = VV + buf * 1024 + v;
#pragma unroll 1
        for (int t4 = 0; t4 < 32; t4 += 4) {
            f32x4 f0[4], f1[4], q0[4], q1[4]; float vv[4], po[4];
#pragma unroll
            for (int j = 0; j < 4; ++j) { const int t = t4 + j;
                f0[j] = *(const LAS f32x4*)(fp + t * 128); f1[j] = *(const LAS f32x4*)(fp + t * 128 + 4);
                q0[j] = *(const LAS f32x4*)(qp + t * 128); q1[j] = *(const LAS f32x4*)(qp + t * 128 + 4); vv[j] = vp[t * 32]; }
#pragma unroll
            for (int j = 0; j < 4; ++j) {
                float p = 0.f;
#pragma unroll
                for (int e = 0; e < 4; ++e) { S[e] = f0[j][e] * S[e] + (1.f - f0[j][e]) * vv[j]; p += q0[j][e] * S[e]; }
#pragma unroll
                for (int e = 0; e < 4; ++e) { S[4 + e] = f1[j][e] * S[4 + e] + (1.f - f1[j][e]) * vv[j]; p += q1[j][e] * S[4 + e]; }
                po[j] = p;
            }
#pragma unroll
            for (int j = 0; j < 4; ++j) { float a, b2; b2 = swap32_other(po[j], a); PART[(t4 + j) * 256 + wave * 32 + v] = a + b2; }
        }
        __syncthreads();
        {
            const int idx = tid * 2, t = idx >> 5, v2 = idx & 31;
            float s0 = 0.f, s1 = 0.f;
#pragma unroll
            for (int w = 0; w < 8; ++w) { const f32x2 p = *(const LAS f32x2*)(PART + t * 256 + w * 32 + v2); s0 += p.x; s1 += p.y; }
            *(f32x2*)(ohg + (rowb + c * 32 + t) * 1024 + h * 128 + vs * 32 + v2) = (f32x2){s0, s1};
        }
        if (c + 1 < 64) HG_STORE(buf ^ 1);
    }
    __syncthreads();
#undef HG_LOAD
#undef HG_STORE
}

__device__ __forceinline__ void hgrn_unit_mma(Frame& F, const Args& A, int l, int u) {
    const int b = u >> 5, h = (u >> 2) & 7, vs = u & 3;
    const int tid = F.tid, lane = F.lane, wave = F.wave, n = lane & 15, q = lane >> 4;
    const bf16* proj = (const bf16*)(F.ws + WS_PROJ);
    float* ohg = (float*)(F.ws + WS_OHG);
    LAS bf16* SCR = (LAS bf16*)(F.lds);
    LAS bf16* VT = (LAS bf16*)(F.lds + 65536);
    LAS float* DL = (LAS float*)(F.lds + 73728);
    LAS float* OP = (LAS float*)(F.lds + 77824);
    LAS float* LB = (LAS float*)(F.lds + 98304);
    __syncthreads();
    if (tid < 128) { float lb = 0.f; if (l == 1) { const float* lg = (const float*)ain_(A, I_LBLOG); lb = sigmoidf_(lg[1024 + h * 128 + tid] - lg[h * 128 + tid]); } LB[tid] = lb; }
    __syncthreads();
    const int kc = n, tq = q;
    float lb8[8];
#pragma unroll
    for (int e = 0; e < 8; ++e) lb8[e] = LB[8 * kc + e];
    const size_t rowb = (size_t)b * SEQ;
    const int nt = wave & 1, kq = wave >> 1;
    f32x4 S0 = {0.f, 0.f, 0.f, 0.f}, S1 = {0.f, 0.f, 0.f, 0.f};
    LAS bf16* scr = SCR + wave * 4096;
    u32x4 rf[4];
#define HGM_LOAD(mcx) do { const int tk_ = (mcx) * 128 + wave * 16; \
        _Pragma("unroll") for (int i = 0; i < 4; ++i) rf[i] = *(const u32x4*)(proj + (rowb + tk_ + 4 * tq + i) * PLD + C_HF + h * 128 + 8 * kc); } while (0)
    HGM_LOAD(0);
    for (int mc = 0; mc < 16; ++mc) {
        const int tok0 = mc * 128 + wave * 16;
        u32x4 rq[4];
#pragma unroll
        for (int i = 0; i < 4; ++i) rq[i] = *(const u32x4*)(proj + (rowb + tok0 + 4 * tq + i) * PLD + C_HQ + h * 128 + 8 * kc);
        const u32x4 rv = *(const u32x4*)(proj + (rowb + tok0 + (lane >> 2)) * PLD + C_HI + h * 128 + vs * 32 + 8 * (lane & 3));
        float fq_[4][8], kq_[4][8], bb[4][8];
#pragma unroll
        for (int i = 0; i < 4; ++i) {
            const unsigned qw[4] = {rq[i].x, rq[i].y, rq[i].z, rq[i].w}, fw[4] = {rf[i].x, rf[i].y, rf[i].z, rf[i].w};
#pragma unroll
            for (int e = 0; e < 8; ++e) {
                const float x = (e & 1) ? bfhi(fw[e >> 1]) : bflo(fw[e >> 1]);
                const float f = lb8[e] + (1.f - lb8[e]) * sigmoidf_(x);
                fq_[i][e] = (e & 1) ? bfhi(qw[e >> 1]) : bflo(qw[e >> 1]);
                kq_[i][e] = 1.f - f;
                const float lf = __builtin_amdgcn_logf(f);
                bb[i][e] = (i ? bb[i - 1][e] : 0.f) + lf;
            }
        }
        float tot[8], bref[8];
#pragma unroll
        for (int e = 0; e < 8; ++e) {
            const float x = bb[3][e];
            float a, b2;
            { auto rr = __builtin_amdgcn_permlane16_swap(__float_as_uint(x), __float_as_uint(x), false, false); a = __uint_as_float((tq & 1) ? rr[0] : rr[1]); }
            const float P = x + a;
            { auto rr = __builtin_amdgcn_permlane32_swap(__float_as_uint(P), __float_as_uint(P), false, false); b2 = __uint_as_float((tq & 2) ? rr[0] : rr[1]); }
            const float pre = ((tq & 1) ? a : 0.f) + ((tq & 2) ? b2 : 0.f);
            tot[e] = P + b2;
#pragma unroll
            for (int i = 0; i < 4; ++i) bb[i][e] += pre;
            bref[e] = __shfl(bb[3][e], kc + 16);
        }
#pragma unroll
        for (int i = 0; i < 4; ++i) {
            float km[8], qm[8];
#pragma unroll
            for (int e = 0; e < 8; ++e) { km[e] = kq_[i][e] * __builtin_amdgcn_exp2f(bref[e] - bb[i][e]); qm[e] = fq_[i][e] * __builtin_amdgcn_exp2f(bb[i][e] - bref[e]); }
            *(LAS u32x4*)(scr + (4 * tq + i) * 128 + 8 * kc) = (u32x4){pk2(km[0], km[1]), pk2(km[2], km[3]), pk2(km[4], km[5]), pk2(km[6], km[7])};
            *(LAS u32x4*)(scr + 2048 + (4 * tq + i) * 128 + 8 * kc) = (u32x4){pk2(qm[0], qm[1]), pk2(qm[2], qm[3]), pk2(qm[4], qm[5]), pk2(qm[6], qm[7])};
        }
        {
            const unsigned vw[4] = {rv.x, rv.y, rv.z, rv.w}; LAS bf16* vt = VT + wave * 512;
#pragma unroll
            for (int e = 0; e < 4; ++e) { vt[(8 * (lane & 3) + 2 * e) * 16 + (lane >> 2)] = (bf16)(vw[e] & 0xffffu); vt[(8 * (lane & 3) + 2 * e + 1) * 16 + (lane >> 2)] = (bf16)(vw[e] >> 16); }
        }
        LDS_WAIT(); asm volatile("" ::: "memory");
        f32x4 at = {0.f, 0.f, 0.f, 0.f};
#pragma unroll
        for (int ks = 0; ks < 4; ++ks) at = mma16(*(const LAS bf16x8*)(scr + n * 128 + 32 * ks + 8 * q), *(const LAS bf16x8*)(scr + 2048 + n * 128 + 32 * ks + 8 * q), at);
#pragma unroll
        for (int r = 0; r < 4; ++r) at[r] = (4 * q + r <= n) ? at[r] : 0.f;
        f32x4 oi[2];
        {
            const u32x4 aw = {pg8::cvt_pk_bf16(at[0], at[1]), pg8::cvt_pk_bf16(at[2], at[3]), 0u, 0u};
#pragma unroll
            for (int t2 = 0; t2 < 2; ++t2) { const u32x2 vv = *(const LAS u32x2*)(VT + wave * 512 + (16 * t2 + n) * 16 + 4 * q);
                oi[t2] = mma16(__builtin_bit_cast(bf16x8, aw), __builtin_bit_cast(bf16x8, (u32x4){vv.x, vv.y, 0u, 0u}), (f32x4){0.f, 0.f, 0.f, 0.f}); }
        }
        LDS_WAIT(); asm volatile("" ::: "memory");
#pragma unroll
        for (int i = 0; i < 4; ++i) {
            float qh[8];
#pragma unroll
            for (int e = 0; e < 8; ++e) qh[e] = fq_[i][e] * __builtin_amdgcn_exp2f(bb[i][e]);
            *(LAS u32x4*)(scr + (4 * tq + i) * 128 + 8 * kc) = (u32x4){pk2(qh[0], qh[1]), pk2(qh[2], qh[3]), pk2(qh[4], qh[5]), pk2(qh[6], qh[7])};
        }
#pragma unroll
        for (int e = 0; e < 8; ++e) {
            float kh[4];
#pragma unroll
            for (int i = 0; i < 4; ++i) kh[i] = kq_[i][e] * __builtin_amdgcn_exp2f(tot[e] - bb[i][e]);
            *(LAS u32x2*)(scr + 2048 + (8 * kc + e) * 16 + 4 * tq) = (u32x2){pk2(kh[0], kh[1]), pk2(kh[2], kh[3])};
        }
        if (tq == 0) {
            *(LAS f32x4*)(DL + wave * 128 + 8 * kc) = (f32x4){__builtin_amdgcn_exp2f(tot[0]), __builtin_amdgcn_exp2f(tot[1]), __builtin_amdgcn_exp2f(tot[2]), __builtin_amdgcn_exp2f(tot[3])};
            *(LAS f32x4*)(DL + wave * 128 + 8 * kc + 4) = (f32x4){__builtin_amdgcn_exp2f(tot[4]), __builtin_amdgcn_exp2f(tot[5]), __builtin_amdgcn_exp2f(tot[6]), __builtin_amdgcn_exp2f(tot[7])};
        }
        __builtin_amdgcn_sched_barrier(0);
        if (mc + 1 < 16) HGM_LOAD(mc + 1);
        __builtin_amdgcn_sched_barrier(0);
        asm volatile("s_waitcnt lgkmcnt(0)\n\ts_barrier" ::: "memory");
        for (int c = 0; c < 8; ++c) {
            const LAS bf16* qh = SCR + c * 4096; const LAS bf16* kht = qh + 2048; const int par = c & 1;
            {
                const u32x2 lo = *(const LAS u32x2*)(qh + n * 128 + 32 * kq + 4 * q), hi = *(const LAS u32x2*)(qh + n * 128 + 32 * kq + 16 + 4 * q);
                const u32x4 sw = {pg8::cvt_pk_bf16(S0[0], S0[1]), pg8::cvt_pk_bf16(S0[2], S0[3]), pg8::cvt_pk_bf16(S1[0], S1[1]), pg8::cvt_pk_bf16(S1[2], S1[3])};
                const f32x4 op = mma16(__builtin_bit_cast(bf16x8, (u32x4){lo.x, lo.y, hi.x, hi.y}), __builtin_bit_cast(bf16x8, sw), (f32x4){0.f, 0.f, 0.f, 0.f});
                LAS float* od = OP + par * 2560 + kq * 512 + 16 * nt + n;
#pragma unroll
                for (int r = 0; r < 4; ++r) od[(4 * q + r) * 32] = op[r];
                if (wave == c) { LAS float* oe = OP + par * 2560 + 4 * 512 + n;
#pragma unroll
                    for (int t2 = 0; t2 < 2; ++t2)
#pragma unroll
                        for (int r = 0; r < 4; ++r) oe[(4 * q + r) * 32 + 16 * t2] = oi[t2][r]; }
            }
            {
                const u32x4 z4 = {0u, 0u, 0u, 0u};
                const u32x4 vb = q < 2 ? *(const LAS u32x4*)(VT + c * 512 + (16 * nt + n) * 16 + 8 * q) : z4;
                const f32x4 d0 = *(const LAS f32x4*)(DL + c * 128 + 32 * kq + 4 * q), d1 = *(const LAS f32x4*)(DL + c * 128 + 32 * kq + 16 + 4 * q);
                const u32x4 ka0 = q < 2 ? *(const LAS u32x4*)(kht + (32 * kq + n) * 16 + 8 * q) : z4, ka1 = q < 2 ? *(const LAS u32x4*)(kht + (32 * kq + 16 + n) * 16 + 8 * q) : z4;
                S0 = mma16(__builtin_bit_cast(bf16x8, ka0), __builtin_bit_cast(bf16x8, vb), S0 * d0);
                S1 = mma16(__builtin_bit_cast(bf16x8, ka1), __builtin_bit_cast(bf16x8, vb), S1 * d1);
            }
            asm volatile("s_waitcnt lgkmcnt(0)\n\ts_barrier" ::: "memory");
            {
                const int t = tid >> 5, v = tid & 31; const LAS float* os = OP + par * 2560 + t * 32 + v;
                const float o = ((os[0] + os[512]) + (os[1024] + os[1536])) + os[2048];
                ohg[(rowb + mc * 128 + c * 16 + t) * 1024 + h * 128 + vs * 32 + v] = o;
            }
        }
        asm volatile("s_waitcnt lgkmcnt(0)\n\ts_barrier" ::: "memory");
    }
#undef HGM_LOAD
    __syncthreads();
}

__device__ __forceinline__ void compress_unit(Frame& F, int u) {
    const int kv = u >> 7, b = (u >> 4) & 7, g = (u >> 3) & 1, cg = u & 7;
    const int lane = F.lane, wave = F.wave, tid = F.tid, n = lane & 15, q = lane >> 4;
    const bf16* proj = (const bf16*)(F.ws + WS_PROJ);
    const bf16* w1t = (const bf16*)(F.ws + WS_CW1) + (size_t)kv * 128 * WLD;
    const bf16* w2t = (const bf16*)(F.ws + WS_SMALL + SM_CW2) + kv * 128 * 128;
    const float* bias1 = (const float*)(F.ws + WS_SMALL + SM_BIAS1) + kv * 128;
    LAS float* RED = (LAS float*)(F.lds);
    LAS bf16* HB = (LAS bf16*)(F.lds + 65536);
    const int csrc = (kv ? C_VC : C_KC) + g * 128;
    int cpos = 16 * cg + n; if (cpos > 126) cpos = 126;
    f32x4 acc[8];
#pragma unroll
    for (int nt = 0; nt < 8; ++nt) acc[nt] = (f32x4){0.f, 0.f, 0.f, 0.f};
    for (int jj = 0; jj < 4; ++jj) {
        const int j = wave * 4 + jj;
        const bf16* arow = proj + ((size_t)b * SEQ + 16 * cpos + j) * PLD + csrc + 8 * q;
#pragma unroll
        for (int ks = 0; ks < 4; ++ks) {
            const bf16x8 af = *(const bf16x8*)(arow + 32 * ks);
#pragma unroll
            for (int nt = 0; nt < 8; ++nt) {
                const bf16x8 bfr = *(const bf16x8*)(w1t + (size_t)(16 * nt + n) * WLD + j * 128 + 32 * ks + 8 * q);
                acc[nt] = mma16(af, bfr, acc[nt]);
            }
        }
    }
#pragma unroll
    for (int nt = 0; nt < 8; ++nt)
#pragma unroll
        for (int r = 0; r < 4; ++r) RED[wave * 2048 + (4 * q + r) * 128 + 16 * nt + n] = acc[nt][r];
    __syncthreads();
    {
        const int r = tid >> 5, c4 = (tid & 31) * 4;
        f32x4 s = *(const f32x4*)(bias1 + c4);
#pragma unroll
        for (int w = 0; w < 8; ++w) s = s + *(const LAS f32x4*)(RED + w * 2048 + r * 128 + c4);
        float o[4];
#pragma unroll
        for (int e = 0; e < 4; ++e) { const float x = s[e]; const float y = 0.7978845608028654f * (x + 0.044715f * x * x * x); const float th = 1.f - 2.f / (__expf(2.f * y) + 1.f); o[e] = 0.5f * x * (1.f + th); }
        *(LAS u32x2*)(HB + r * 136 + c4) = (u32x2){pk2(o[0], o[1]), pk2(o[2], o[3])};
    }
    __syncthreads();
    {
        f32x4 a2 = {0.f, 0.f, 0.f, 0.f};
#pragma unroll
        for (int ks = 0; ks < 4; ++ks) {
            const bf16x8 af = *(const LAS bf16x8*)(HB + n * 136 + 32 * ks + 8 * q);
            const bf16x8 bfr = *(const bf16x8*)(w2t + (16 * wave + n) * 128 + 32 * ks + 8 * q);
            a2 = mma16(af, bfr, a2);
        }
        const int dim = 16 * wave + n;
        if (kv == 0) {
            bf16* kc = (bf16*)(F.ws + WS_KCMP) + (size_t)(b * 2 + g) * 128 * 128;
#pragma unroll
            for (int r = 0; r < 4; ++r) { const int c = 16 * cg + 4 * q + r; kc[kt_off(c, dim)] = (bf16)(c < 127 ? f2bf(a2[r]) : 0u); }
        } else {
            bf16* vt = (bf16*)(F.ws + WS_KCMP + 524288) + (size_t)(b * 2 + g) * 128 * 128;
            float o[4];
#pragma unroll
            for (int r = 0; r < 4; ++r) o[r] = (16 * cg + 4 * q + r < 127) ? a2[r] : 0.f;
            *(u32x2*)(vt + (cg >> 1) * 4096 + dim * 32 + 8 * q + 4 * (cg & 1)) = (u32x2){pk2(o[0], o[1]), pk2(o[2], o[3])};
        }
    }
    __syncthreads();
}

__device__ __forceinline__ void vtrans_unit(Frame& F, int u) {
    const int br = u >> 9, b = (u >> 6) & 7, g = (u >> 5) & 1, tb = u & 31;
    const int tid = F.tid;
    const bf16* proj = (const bf16*)(F.ws + WS_PROJ);
    LAS bf16* T = (LAS bf16*)(F.lds);
    bf16* vT = (bf16*)(F.ws + (br ? WS_VWT : WS_VST)) + (size_t)(b * 2 + g) * 128 * SEQ;
    {
        const int tt = tid >> 3, part = tid & 7;
        const bf16* src = proj + ((size_t)b * SEQ + tb * 64 + tt) * PLD + (br ? C_VW : C_VS) + g * 128 + 16 * part;
        const u32x4 a = *(const u32x4*)src, c = *(const u32x4*)(src + 8);
        const unsigned w[8] = {a.x, a.y, a.z, a.w, c.x, c.y, c.z, c.w};
#pragma unroll
        for (int e = 0; e < 8; ++e) { T[(16 * part + 2 * e) * 72 + tt] = (bf16)(w[e] & 0xffffu); T[(16 * part + 2 * e + 1) * 72 + tt] = (bf16)(w[e] >> 16); }
    }
    __syncthreads();
    {
        const int d = tid >> 2, part = tid & 3, blkl = part >> 1, half = part & 1;
        unsigned w[8];
#pragma unroll
        for (int e = 0; e < 8; ++e) {
            const int p0 = 16 * half + 2 * e, p1 = p0 + 1;
            const int k0 = 16 * ((p0 >> 2) & 1) + 4 * (p0 >> 3) + (p0 & 3), k1 = 16 * ((p1 >> 2) & 1) + 4 * (p1 >> 3) + (p1 & 3);
            w[e] = (unsigned)T[d * 72 + 32 * blkl + k0] | ((unsigned)T[d * 72 + 32 * blkl + k1] << 16);
        }
        bf16* dst = vT + (size_t)(2 * tb + blkl) * 4096 + d * 32 + 16 * half;
        *(u32x4*)dst = (u32x4){w[0], w[1], w[2], w[3]}; *(u32x4*)(dst + 8) = (u32x4){w[4], w[5], w[6], w[7]};
    }
    __syncthreads();
}

__device__ __forceinline__ void rope_pair(const bf16* s1, const bf16* s2, bf16* d1, bf16* d2, const float* rc, const float* rs) {
    const u32x4 a = *(const u32x4*)s1, c = *(const u32x4*)s2;
    const f32x4 c0 = *(const f32x4*)rc, c1 = *(const f32x4*)(rc + 4), s0 = *(const f32x4*)rs, s1v = *(const f32x4*)(rs + 4);
    const unsigned aw[4] = {a.x, a.y, a.z, a.w}, cw[4] = {c.x, c.y, c.z, c.w};
    const float cs[8] = {c0[0], c0[1], c0[2], c0[3], c1[0], c1[1], c1[2], c1[3]}, sn[8] = {s0[0], s0[1], s0[2], s0[3], s1v[0], s1v[1], s1v[2], s1v[3]};
    unsigned o1[4], o2[4];
#pragma unroll
    for (int e = 0; e < 4; ++e) {
        const float x1l = bflo(aw[e]), x1h = bfhi(aw[e]), x2l = bflo(cw[e]), x2h = bfhi(cw[e]);
        o1[e] = pk2(x1l * cs[2 * e] - x2l * sn[2 * e], x1h * cs[2 * e + 1] - x2h * sn[2 * e + 1]);
        o2[e] = pk2(x2l * cs[2 * e] + x1l * sn[2 * e], x2h * cs[2 * e + 1] + x1h * sn[2 * e + 1]);
    }
    *(u32x4*)d1 = (u32x4){o1[0], o1[1], o1[2], o1[3]}; *(u32x4*)d2 = (u32x4){o2[0], o2[1], o2[2], o2[3]};
}
__device__ __forceinline__ void rope_pool_pass(Frame& F, bool do_krope) {
    bf16* proj = (bf16*)(F.ws + WS_PROJ); bf16* qs = (bf16*)(F.ws + WS_QS); bf16* mixed = (bf16*)(F.ws + WS_MIXED);
    const float* rc = (const float*)(F.ws + WS_ROPE); const float* rs = rc + NTOK * 16;
    const int gt = F.gw * 64 + F.lane, NT = F.NGW * 64;
    (void)do_krope;
    {
        constexpr int NQ = NTOK * 16 * 12, NK = NTOK * 4 * 12;
        for (int base = gt; base < NQ + NK; base += 4 * NT) {
            u32x4 v[4]; bf16* d[4];
#pragma unroll
            for (int k = 0; k < 4; ++k) { const int it = base + k * NT; d[k] = nullptr;
                if (it < NQ) { const int m = it / 192, r = it - m * 192, hd = r / 12, ch = 4 + (r - hd * 12);
                    v[k] = *(const u32x4*)(proj + (size_t)m * PLD + C_Q + hd * 128 + 8 * ch); d[k] = qs + (size_t)m * 2048 + hd * 128 + 8 * ch; }
                else if (it < NQ + NK) { const int i2 = it - NQ, m = i2 / 48, r = i2 - m * 48, bg = r / 12, ch = 4 + (r - bg * 12), br = bg >> 1, g = bg & 1;
                    v[k] = *(const u32x4*)(proj + (size_t)m * PLD + (br ? C_KW : C_KS) + g * 128 + 8 * ch);
                    d[k] = (bf16*)(F.ws + (br ? WS_KWT : WS_KST)) + (size_t)((m >> 11) * 2 + g) * SEQ * 128 + kt_off(m & (SEQ - 1), 8 * ch); } }
#pragma unroll
            for (int k = 0; k < 4; ++k) if (d[k]) *(u32x4*)d[k] = v[k];
        }
    }
    {
        constexpr int NQ = NTOK * 16 * 2, NK = NTOK * 4 * 2;
        for (int it = gt; it < NQ + NK; it += NT) {
            if (it < NQ) { const int m = it >> 5, hd = (it >> 1) & 15, ch = it & 1;
                const bf16* sp = proj + (size_t)m * PLD + C_Q + hd * 128 + 8 * ch; bf16* dp = qs + (size_t)m * 2048 + hd * 128 + 8 * ch;
                rope_pair(sp, sp + 16, dp, dp + 16, rc + m * 16 + 8 * ch, rs + m * 16 + 8 * ch); }
            else { const int i2 = it - NQ, m = i2 >> 3, bg = (i2 >> 1) & 3, ch = i2 & 1, br = bg >> 1, g = bg & 1;
                const bf16* sp = proj + (size_t)m * PLD + (br ? C_KW : C_KS) + g * 128 + 8 * ch;
                bf16* dp = (bf16*)(F.ws + (br ? WS_KWT : WS_KST)) + (size_t)((m >> 11) * 2 + g) * SEQ * 128 + kt_off(m & (SEQ - 1), 8 * ch);
                rope_pair(sp, sp + 16, dp, dp + 16, rc + m * 16 + 8 * ch, rs + m * 16 + 8 * ch); }
        }
    }
#define POOL_LOOP(GI, W) \
    for (int it = gt; it < NTOK * 32; it += NT) { \
        const int m = it >> 5, ch = (GI) * 32 + (it & 31), s = m & (SEQ - 1), cnt = (s + 1 < (W)) ? s + 1 : (W); \
        const bf16* p = proj + (size_t)m * PLD + C_PIN + 8 * ch; \
        u32x4 a[W]; \
        _Pragma("unroll") for (int j = 0; j < (W); ++j) a[j] = j < cnt ? *(const u32x4*)(p - (size_t)j * PLD) : (u32x4){0u, 0u, 0u, 0u}; \
        float acc[8]; \
        _Pragma("unroll") for (int e = 0; e < 8; ++e) acc[e] = 0.f; \
        _Pragma("unroll") for (int j = 0; j < (W); ++j) { const unsigned aw[4] = {a[j].x, a[j].y, a[j].z, a[j].w}; \
            _Pragma("unroll") for (int e = 0; e < 4; ++e) { acc[2 * e] += bflo(aw[e]); acc[2 * e + 1] += bfhi(aw[e]); } } \
        const float inv = 1.f / (float)cnt; const unsigned ow[4] = {a[0].x, a[0].y, a[0].z, a[0].w}; \
        u32x4 o; o.x = pk2(acc[0] * inv - bflo(ow[0]), acc[1] * inv - bfhi(ow[0])); o.y = pk2(acc[2] * inv - bflo(ow[1]), acc[3] * inv - bfhi(ow[1])); \
        o.z = pk2(acc[4] * inv - bflo(ow[2]), acc[5] * inv - bfhi(ow[2])); o.w = pk2(acc[6] * inv - bflo(ow[3]), acc[7] * inv - bfhi(ow[3])); \
        *(u32x4*)(mixed + (size_t)m * 1024 + 8 * ch) = o; }
    POOL_LOOP(0, 2) POOL_LOOP(1, 4) POOL_LOOP(2, 8) POOL_LOOP(3, 16)
#undef POOL_LOOP
}

__device__ __forceinline__ void cmp_attn_item(Frame& F, int b, int g, int tA, LAS float* PS) {
    const int lane = F.lane, n = lane & 15, q = lane >> 4, tp = n >> 3, head = g * 8 + (n & 7);
    const int s_tok = tA + tp; const size_t m = (size_t)b * SEQ + s_tok;
    const bf16* proj = (const bf16*)(F.ws + WS_PROJ);
    const bf16* kc = (const bf16*)(F.ws + WS_KCMP) + (size_t)(b * 2 + g) * 128 * 128;
    const bf16* vt = (const bf16*)(F.ws + WS_KCMP + 524288) + (size_t)(b * 2 + g) * 128 * 128;
    float* yaf = (float*)(F.ws + WS_YAF);
    bf16x8 qf[4];
#pragma unroll
    for (int ks = 0; ks < 4; ++ks) qf[ks] = *(const bf16x8*)(proj + m * PLD + C_Q + head * 128 + 32 * ks + 8 * q);
    const int tmax = tA + 1;
    const int nkt = tmax >= 31 ? (((tmax - 31) >> 4) >> 4) + 1 : 0;
    f32x4 p[8];
    float mx = -1e30f;
#pragma unroll
    for (int kt = 0; kt < 8; ++kt) {
        if (kt < nkt) {
            f32x4 a = {0.f, 0.f, 0.f, 0.f};
#pragma unroll
            for (int ks = 0; ks < 4; ++ks) { const bf16x8 kf = *(const bf16x8*)(kc + kt * 2048 + ks * 512 + n * 32 + 8 * q); a = mma16(kf, qf[ks], a); }
#pragma unroll
            for (int r = 0; r < 4; ++r) { const int c = 16 * kt + 4 * q + r; a[r] = (16 * c + 31 <= s_tok) ? a[r] * (ATT_SCALE * LOG2E) : NEG_INF; }
            p[kt] = a; mx = fmaxf(mx, max4(a));
        } else p[kt] = (f32x4){NEG_INF, NEG_INF, NEG_INF, NEG_INF};
    }
    mx = xor_max_q(mx);
    float l = 0.f;
#pragma unroll
    for (int kt = 0; kt < 8; ++kt) {
#pragma unroll
        for (int r = 0; r < 4; ++r) p[kt][r] = __builtin_amdgcn_exp2f(p[kt][r] - mx);
        l += sum4(p[kt]);
    }
    l = xor_sum_q(l);
    const float inv = l > 0.f ? 1.f / l : 0.f;
#pragma unroll
    for (int kt = 0; kt < 8; ++kt) {
        p[kt] = p[kt] * inv;
#pragma unroll
        for (int r = 0; r < 4; ++r) { float v = p[kt][r]; v += __shfl_xor(v, 1); v += __shfl_xor(v, 2); v += __shfl_xor(v, 4); if ((n & 7) == 0) PS[tp * 128 + 16 * kt + 4 * q + r] = v; }
    }
    f32x4 o[8];
#pragma unroll
    for (int nt = 0; nt < 8; ++nt) o[nt] = (f32x4){0.f, 0.f, 0.f, 0.f};
#pragma unroll
    for (int j = 0; j < 4; ++j) {
        if (2 * j < nkt) {
            const bf16x8 pb = pack_p(p[2 * j], p[2 * j + 1]);
#pragma unroll
            for (int nt = 0; nt < 8; ++nt) {
                o[nt] = mma16(*(const bf16x8*)(vt + j * 4096 + (16 * nt + n) * 32 + 8 * q), pb, o[nt]);
            }
        }
    }
    const float g0 = sigmoidf_(bf1(proj[m * PLD + C_AG + head]));
#pragma unroll
    for (int nt = 0; nt < 8; ++nt) *(f32x4*)(yaf + m * 2048 + head * 128 + 16 * nt + 4 * q) = o[nt] * g0;
    LDS_WAIT(); asm volatile("" ::: "memory");
    unsigned long long* sel = (unsigned long long*)(F.ws + WS_SEL);
#pragma unroll
    for (int t2 = 0; t2 < 2; ++t2) {
        const int t = tA + t2, blk = t >> 5, nb = lane;
        float imp = 2.f * PS[t2 * 128 + 2 * nb] + PS[t2 * 128 + 2 * nb + 1]; if (nb > 0) imp += PS[t2 * 128 + 2 * nb - 1];
        const bool forced = (nb == 0) || (nb == blk) || (nb == blk - 1);
        const float val = forced ? __builtin_inff() : (nb <= blk ? imp : NEG_INF);
        const int rank = rank64(val, lane, PS + 256);
        const unsigned long long msk = __ballot(rank < 8 && nb <= blk);
        if (lane == 0) sel[((size_t)b * SEQ + t) * 2 + g] = msk;
    }
    LDS_WAIT(); asm volatile("" ::: "memory");
}

__device__ __forceinline__ void win_attn_unit(Frame& F, int b, int g, int tb) {
    const int lane = F.lane, n = lane & 15, q = lane >> 4, wave = F.wave;
    const int t0 = 32 * tb + 16 * (wave & 1), hp = wave >> 1;
    const int s_tok = t0 + n; const size_t m = (size_t)b * SEQ + s_tok;
    const bf16* proj = (const bf16*)(F.ws + WS_PROJ); const bf16* qs = (const bf16*)(F.ws + WS_QS);
    const char* ksrc = (const char*)(F.ws + WS_KWT) + (size_t)(b * 2 + g) * SEQ * 256 + F.tid * 16;
    const char* vsrc = (const char*)(F.ws + WS_VWT) + (size_t)(b * 2 + g) * SEQ * 256 + F.tid * 16;
    const float* yaf = (const float*)(F.ws + WS_YAF); float* yaf2 = (float*)(F.ws + WS_YAF2);
    LAS unsigned char* ring = F.lds;
    const int h0 = g * 8 + 2 * hp;
    bf16x8 qf[2][4];
#pragma unroll
    for (int hd = 0; hd < 2; ++hd)
#pragma unroll
        for (int ks = 0; ks < 4; ++ks) qf[hd][ks] = *(const bf16x8*)(qs + m * 2048 + (h0 + hd) * 128 + 32 * ks + 8 * q);
    f32x4 o[2][8];
#pragma unroll
    for (int hd = 0; hd < 2; ++hd)
#pragma unroll
        for (int nt = 0; nt < 8; ++nt) o[hd][nt] = (f32x4){0.f, 0.f, 0.f, 0.f};
    float mrun[2] = {-1e30f, -1e30f}, lrun[2] = {0.f, 0.f};
    const int blo = tb >= 16 ? tb - 16 : 0, nb = tb - blo + 1;
#define WIN_DMA(bi, slot) do { \
        __builtin_amdgcn_global_load_lds((const unsigned*)(ksrc + (size_t)(bi) * 8192), (LAS unsigned*)(ring + (slot) * 16384 + wave * 1024), 16, 0, 0); \
        __builtin_amdgcn_global_load_lds((const unsigned*)(vsrc + (size_t)(bi) * 8192), (LAS unsigned*)(ring + (slot) * 16384 + 8192 + wave * 1024), 16, 0, 0); } while (0)
    asm volatile("s_barrier" ::: "memory");
    WIN_DMA(blo, 0);
    if (nb > 1) WIN_DMA(blo + 1, 1);
    for (int i = 0; i < nb; ++i) {
        const int bi = blo + i, slot = i % 3;
        if (i + 1 < nb) asm volatile("s_waitcnt vmcnt(2)\n\ts_barrier" ::: "memory"); else asm volatile("s_waitcnt vmcnt(0)\n\ts_barrier" ::: "memory");
        if (i + 2 < nb) WIN_DMA(bi + 2, (i + 2) % 3);
        const LAS unsigned char* kl = ring + slot * 16384 + (n * 32 + 8 * q) * 2; const LAS unsigned char* vl = kl + 8192;
        f32x4 s[2][2];
#pragma unroll
        for (int tl = 0; tl < 2; ++tl) {
            s[0][tl] = (f32x4){0.f, 0.f, 0.f, 0.f}; s[1][tl] = (f32x4){0.f, 0.f, 0.f, 0.f};
#pragma unroll
            for (int ks = 0; ks < 4; ++ks) { const bf16x8 kf = *(const LAS bf16x8*)(kl + tl * 4096 + ks * 1024);
                s[0][tl] = mma16(kf, qf[0][ks], s[0][tl]); s[1][tl] = mma16(kf, qf[1][ks], s[1][tl]); }
        }
        const bool interior = (32 * bi >= t0 - 496) && (32 * bi + 31 <= t0);
#pragma unroll
        for (int tl = 0; tl < 2; ++tl)
#pragma unroll
            for (int r = 0; r < 4; ++r) {
                const int key = 32 * bi + 16 * tl + 4 * q + r;
                const bool ok = interior || (key <= s_tok && s_tok - key < 512);
                s[0][tl][r] = ok ? s[0][tl][r] * (ATT_SCALE * LOG2E) : NEG_INF; s[1][tl][r] = ok ? s[1][tl][r] * (ATT_SCALE * LOG2E) : NEG_INF;
            }
        bf16x8 pb[2];
#pragma unroll
        for (int hd = 0; hd < 2; ++hd) {
            float tm = xor_max_q(fmaxf(max4(s[hd][0]), max4(s[hd][1])));
            const float mnew = fmaxf(mrun[hd], tm);
            const float alpha = __builtin_amdgcn_exp2f(mrun[hd] - mnew);
#pragma unroll
            for (int tl = 0; tl < 2; ++tl)
#pragma unroll
                for (int r = 0; r < 4; ++r) s[hd][tl][r] = __builtin_amdgcn_exp2f(s[hd][tl][r] - mnew);
            const float ps = xor_sum_q(sum4(s[hd][0]) + sum4(s[hd][1]));
            lrun[hd] = lrun[hd] * alpha + ps; mrun[hd] = mnew;
#pragma unroll
            for (int nt = 0; nt < 8; ++nt) o[hd][nt] = o[hd][nt] * alpha;
            pb[hd] = pack_p(s[hd][0], s[hd][1]);
        }
#pragma unroll
        for (int nt = 0; nt < 8; ++nt) {
            const bf16x8 vf = *(const LAS bf16x8*)(vl + nt * 1024);
            o[0][nt] = mma16(vf, pb[0], o[0][nt]); o[1][nt] = mma16(vf, pb[1], o[1][nt]);
        }
    }
#undef WIN_DMA
#pragma unroll
    for (int hd = 0; hd < 2; ++hd) {
        const float g2 = sigmoidf_(bf1(proj[m * PLD + C_AG + 32 + h0 + hd])) / lrun[hd];
#pragma unroll
        for (int nt = 0; nt < 8; ++nt) { const size_t off = m * 2048 + (h0 + hd) * 128 + 16 * nt + 4 * q; *(f32x4*)(yaf2 + off) = *(const f32x4*)(yaf + off) + o[hd][nt] * g2; }
    }
}

__device__ __forceinline__ void sel_load(Frame& F, int b, int g, int s_tok, bf16x8 (&qf)[4], unsigned long long& mk) {
    const int lane = F.lane, n = lane & 15, q = lane >> 4, head = g * 8 + (n & 7);
    const size_t m = (size_t)b * SEQ + s_tok;
    const bf16* qs = (const bf16*)(F.ws + WS_QS);
#pragma unroll
    for (int ks = 0; ks < 4; ++ks) qf[ks] = *(const bf16x8*)(qs + m * 2048 + head * 128 + 32 * ks + 8 * q);
    mk = ((const unsigned long long*)(F.ws + WS_SEL))[m * 2 + g];
}
__device__ __forceinline__ void sel_attn_item(Frame& F, int b, int g, int s_tok, bf16x8 (&qfio)[4], unsigned long long& mkio, bool has_next, int nb, int ng, int ns) {
    const int lane = F.lane, n = lane & 15, q = lane >> 4, head = g * 8 + (n & 7);
    const size_t m = (size_t)b * SEQ + s_tok;
    const bf16* proj = (const bf16*)(F.ws + WS_PROJ);
    const bf16* kbase = (const bf16*)(F.ws + WS_KST) + (size_t)(b * 2 + g) * SEQ * 128 + n * 32 + 8 * q;
    const bf16* vT = (const bf16*)(F.ws + WS_VST) + (size_t)(b * 2 + g) * 128 * SEQ + n * 32 + 8 * q;
    const float* yaf = (const float*)(F.ws + WS_YAF2); bf16* Y = (bf16*)(F.ws + WS_Y);
    bf16x8 qf[4];
#pragma unroll
    for (int ks = 0; ks < 4; ++ks) qf[ks] = qfio[ks];
    const unsigned long long mk = mkio;
    unsigned mlo = (unsigned)__builtin_amdgcn_readfirstlane((int)(unsigned)mk), mhi = (unsigned)__builtin_amdgcn_readfirstlane((int)(unsigned)(mk >> 32));
    unsigned long long mask = ((unsigned long long)mhi << 32) | mlo;
    int blk[8]; bool bok[8];
#pragma unroll
    for (int i = 0; i < 8; ++i) { bok[i] = mask != 0ull; blk[i] = bok[i] ? __builtin_ctzll(mask) : 0; mask &= mask - 1; }
    const f32x4 yprev0 = *(const f32x4*)(yaf + m * 2048 + head * 128 + 4 * q);
    const float gpre = bf1(proj[m * PLD + C_AG + 16 + head]);
    f32x4 p[8][2];
    float mx = -1e30f;
#pragma unroll
    for (int i = 0; i < 8; ++i) {
#pragma unroll
        for (int tl = 0; tl < 2; ++tl) {
            f32x4 a = {0.f, 0.f, 0.f, 0.f};
            const bf16* kr = kbase + (2 * blk[i] + tl) * 2048;
#pragma unroll
            for (int ks = 0; ks < 4; ++ks) a = mma16(*(const bf16x8*)(kr + 512 * ks), qf[ks], a);
#pragma unroll
            for (int r = 0; r < 4; ++r) { const int key = 32 * blk[i] + 16 * tl + 4 * q + r; a[r] = (bok[i] && key <= s_tok) ? a[r] * (ATT_SCALE * LOG2E) : NEG_INF; }
            p[i][tl] = a; mx = fmaxf(mx, max4(a));
        }
    }
    mx = xor_max_q(mx);
    float l = 0.f;
#pragma unroll
    for (int i = 0; i < 8; ++i)
#pragma unroll
        for (int tl = 0; tl < 2; ++tl) {
#pragma unroll
            for (int r = 0; r < 4; ++r) p[i][tl][r] = __builtin_amdgcn_exp2f(p[i][tl][r] - mx);
            l += sum4(p[i][tl]);
        }
    l = xor_sum_q(l);
    f32x4 o[8];
#pragma unroll
    for (int nt = 0; nt < 8; ++nt) o[nt] = (f32x4){0.f, 0.f, 0.f, 0.f};
#pragma unroll
    for (int i = 0; i < 8; ++i) {
        const bf16x8 pb = pack_p(p[i][0], p[i][1]);
#pragma unroll
        for (int nt = 0; nt < 8; ++nt) o[nt] = mma16(*(const bf16x8*)(vT + blk[i] * 4096 + nt * 512), pb, o[nt]);
    }
    if (has_next) sel_load(F, nb, ng, ns, qfio, mkio);
    const float g1 = sigmoidf_(gpre) / l;
    if (n < 8) {
#pragma unroll
        for (int nt = 0; nt < 8; ++nt) {
            const f32x4 pr = nt == 0 ? yprev0 : *(const f32x4*)(yaf + m * 2048 + head * 128 + 16 * nt + 4 * q);
            const f32x4 v = pr + o[nt] * g1;
            *(u32x2*)(Y + m * 4096 + head * 128 + 16 * nt + 4 * q) = (u32x2){pk2(v[0], v[1]), pk2(v[2], v[3])};
        }
    }
}

__device__ __forceinline__ void hgrn_finalize(Frame& F, const Args& A, int l) {
    const bf16* proj = (const bf16*)(F.ws + WS_PROJ); const float* ohg = (const float*)(F.ws + WS_OHG); bf16* Y = (bf16*)(F.ws + WS_Y);
    const float* ng = (const float*)ain_(A, I_HGNG) + (size_t)l * 1024;
    const int lane = F.lane;
    float ngv[16];
#pragma unroll
    for (int e = 0; e < 16; ++e) ngv[e] = ng[16 * lane + e];
    for (int m0 = F.gw; m0 < NTOK; m0 += 2 * F.NGW) {
        const int m1 = m0 + F.NGW; const bool ok1 = m1 < NTOK; const int mr[2] = {m0, ok1 ? m1 : m0};
        f32x4 v[2][4]; u32x4 ga[2], gb[2];
#pragma unroll
        for (int r = 0; r < 2; ++r) { const float* orow = ohg + (size_t)mr[r] * 1024 + 16 * lane;
#pragma unroll
            for (int j = 0; j < 4; ++j) v[r][j] = *(const f32x4*)(orow + 4 * j);
            ga[r] = *(const u32x4*)(proj + (size_t)mr[r] * PLD + C_HG + 16 * lane); gb[r] = *(const u32x4*)(proj + (size_t)mr[r] * PLD + C_HG + 16 * lane + 8); }
#pragma unroll
        for (int r = 0; r < 2; ++r) {
            float ss = 0.f;
#pragma unroll
            for (int j = 0; j < 4; ++j) ss += (v[r][j].x * v[r][j].x + v[r][j].y * v[r][j].y) + (v[r][j].z * v[r][j].z + v[r][j].w * v[r][j].w);
            ss += __shfl_xor(ss, 1); ss += __shfl_xor(ss, 2); ss += __shfl_xor(ss, 4);
            const float rms = 1.f / sqrtf(ss * (1.f / 128.f) + RMS_EPS);
            const unsigned gw_[8] = {ga[r].x, ga[r].y, ga[r].z, ga[r].w, gb[r].x, gb[r].y, gb[r].z, gb[r].w};
            unsigned ow[8];
#pragma unroll
            for (int e = 0; e < 8; ++e) {
                const float a0 = v[r][e >> 1][(2 * e) & 3] * rms * ngv[2 * e] * siluf_(bflo(gw_[e]));
                const float a1 = v[r][e >> 1][(2 * e + 1) & 3] * rms * ngv[2 * e + 1] * siluf_(bfhi(gw_[e]));
                ow[e] = pk2(a0, a1);
            }
            if (r == 0 || ok1) { bf16* d = Y + (size_t)mr[r] * 4096 + 2048 + 16 * lane;
                *(u32x4*)d = (u32x4){ow[0], ow[1], ow[2], ow[3]}; *(u32x4*)(d + 8) = (u32x4){ow[4], ow[5], ow[6], ow[7]}; }
        }
    }
}
using pg8::Unit;
struct SchedTile {
    pg8::TileOrder T; int G, c; const char* A; const char* B; unsigned lda, ldb; int nt;
    __device__ __forceinline__ bool next(int i, Unit& u) const {
        int pm, pn; if (!T.tile((long)i * G + c, pm, pn)) return false;
        u.A = A + (size_t)pm * 256 * lda; u.B = B + (size_t)pn * 256 * ldb; u.rows = nullptr; u.nt = nt; u.epi = 1; u.pm = pm; u.pn = pn; u.aux = 0; u.nvalid = 256; u.rowbase = pm * 256; u.shift = 0; return true;
    }
};
struct SchedP1 {
    pg8::TileOrder T; int G, c; const char* A; const char* B;
    __device__ __forceinline__ bool next(int i, Unit& u) const {
        int pm, pn; if (!T.tile((long)i * G + c, pm, pn)) return false;
        if (pn == 34) pn = 82;
        u.A = A + (size_t)pm * 256 * 8192; u.B = B + (size_t)pn * 256 * (WLD * 2); u.rows = nullptr; u.nt = 64; u.epi = 1; u.pm = pm; u.pn = pn; u.aux = 0; u.nvalid = 256; u.rowbase = pm * 256; u.shift = 0; return true;
    }
};
struct SchedMerge {
    pg8::TileOrder T; int G, c; const char* A; const char* B;
    __device__ __forceinline__ bool next(int i, Unit& u) const {
        const int ti = i / 3, seg = i - 3 * ti; int pm, pn; if (!T.tile((long)ti * G + c, pm, pn)) return false;
        const size_t koff = seg == 0 ? 0 : (seg == 1 ? 4096 : 6144);
        u.A = A + (size_t)pm * 256 * 8192 + koff; u.B = B + (size_t)pn * 256 * (WLD * 2) + koff; u.rows = nullptr; u.nt = seg == 0 ? 32 : 16; u.epi = 1; u.pm = pm; u.pn = pn; u.aux = seg;
        u.nvalid = 256; u.rowbase = pm * 256; u.shift = 0; return true;
    }
};
struct SchedPool {
    int G, c; const char* A; const char* B;
    __device__ __forceinline__ bool next(int i, Unit& u) const {
        const int L = i * G + c; if (L >= 256) return false; const int pm = L >> 2, g = L & 3;
        u.A = A + (size_t)pm * 256 * 2048 + g * 512; u.B = B + (size_t)g * 256 * 512; u.rows = nullptr; u.nt = 4; u.epi = 1; u.pm = pm; u.pn = 0; u.aux = g; u.nvalid = 256; u.rowbase = pm * 256; u.shift = 0; return true;
    }
};
struct SchedRouter {
    int G, c; const char* A; const char* B;
    __device__ __forceinline__ bool next(int i, Unit& u) const {
        const int L = i * G + c; if (L >= 256) return false; const int pm = L >> 2, kq = L & 3;
        u.A = A + (size_t)pm * 256 * 8192 + kq * 2048; u.B = B + kq * 2048; u.rows = nullptr; u.nt = 16; u.epi = 1; u.pm = pm; u.pn = 0; u.aux = kq; u.nvalid = 256; u.rowbase = pm * 256; u.shift = 0; return true;
    }
};
__device__ __forceinline__ void moe_find(const volatile LAS int* tab, int et, int& e, int& tile, int& nvalid) {
    const volatile LAS unsigned short* et2e = (const volatile LAS unsigned short*)(tab + 132);
    const int ee = __builtin_amdgcn_readfirstlane((int)et2e[et]);
    e = ee; tile = __builtin_amdgcn_readfirstlane(et - tab[ee]); const int cnt = __builtin_amdgcn_readfirstlane(tab[65 + ee]);
    nvalid = cnt - tile * 256 < 256 ? cnt - tile * 256 : 256;
}
struct SchedMoe1 {
    int G, c; const volatile LAS int* tab; const char* hb; const char* w13; const char* ws13; const int* plist; int ldbB, ntk;
    __device__ __forceinline__ bool next(int i, Unit& u) const {
        const int L = i * G + c, T = __builtin_amdgcn_readfirstlane(tab[64]);
        if (L >= T + 128) return false;
        u.A = hb; u.nt = ntk; u.epi = 1; u.pn = 0;
        if (L < T) { int e, tile, nv; moe_find(tab, L, e, tile, nv); u.B = w13 + (size_t)e * 256 * ldbB; u.rows = plist + (size_t)e * PCAP + tile * 256; u.nvalid = nv; u.shift = 3; u.rowbase = L * 256; u.pm = -1; u.aux = e; }
        else { const int sh = L - T, pm = sh >> 1, j = sh & 1; u.B = ws13 + (size_t)j * 256 * ldbB; u.rows = nullptr; u.nvalid = 256; u.shift = 0; u.rowbase = pm * 256; u.pm = pm; u.aux = j; }
        return true;
    }
};
struct SchedMoe2 {
    int G, c; const volatile LAS int* tab; const char* hd; const char* w2; const int* plist;
    __device__ __forceinline__ bool next(int i, Unit& u) const {
        const int L = i * G + c, T = __builtin_amdgcn_readfirstlane(tab[64]);
        if (L >= T * 16) return false;
        int e, tile, nv; moe_find(tab, L >> 4, e, tile, nv); const int pn = L & 15;
        u.A = hd + (size_t)(L >> 4) * 256 * 256; u.B = w2 + ((size_t)e * 4096 + pn * 256) * 256; u.rows = plist + (size_t)e * PCAP + tile * 256; u.nvalid = nv; u.shift = 0; u.rowbase = 0; u.nt = 2; u.epi = 1; u.pm = -1; u.pn = pn; u.aux = e;
        return true;
    }
};

typedef const f32x4 (&AccRef)[2][2][4][2];
struct EpiStoreBf16 {
    static constexpr bool PERM = true, I8 = false, PAIR64 = false;
    bf16* O; int ldc;
    __device__ __forceinline__ void operator()(AccRef acc, const Unit& u, int wr, int wc, int fr, int fq, const LAS int* rowsl) const {
        const int row0 = u.pm * 256 + wr * 64 + fr, col0 = u.pn * 256 + wc * 32 + 8 * fq;
#pragma unroll
        for (int ai = 0; ai < 2; ++ai)
#pragma unroll
            for (int m = 0; m < 4; ++m) { bf16* rowp = O + (size_t)(row0 + ai * 128 + m * 16) * ldc + col0;
#pragma unroll
                for (int bj = 0; bj < 2; ++bj) { const f32x4 v0 = acc[ai][bj][m][0], v1 = acc[ai][bj][m][1];
                    u32x4 w; w.x = pg8::cvt_pk_bf16(v0[0], v0[1]); w.y = pg8::cvt_pk_bf16(v0[2], v0[3]); w.z = pg8::cvt_pk_bf16(v1[0], v1[1]); w.w = pg8::cvt_pk_bf16(v1[2], v1[3]);
                    *(u32x4*)(rowp + bj * 128) = w; } }
    }
};
struct EpiStoreI8 {
    static constexpr bool PERM = true, I8 = true, PAIR64 = false;
    bf16* O; int ldc; const float* rs; const float* cs;
    __device__ __forceinline__ void operator()(AccRef acc, const Unit& u, int wr, int wc, int fr, int fq, const LAS int* rowsl) const {
        const int row0 = u.pm * 256 + wr * 64 + fr, col0 = u.pn * 256 + wc * 32 + 8 * fq;
        f32x4 c0[2], c1[2];
#pragma unroll
        for (int bj = 0; bj < 2; ++bj) { c0[bj] = *(const f32x4*)(cs + col0 + bj * 128); c1[bj] = *(const f32x4*)(cs + col0 + bj * 128 + 4); }
        float rr[2][4];
#pragma unroll
        for (int ai = 0; ai < 2; ++ai)
#pragma unroll
            for (int m = 0; m < 4; ++m) rr[ai][m] = rs[row0 + ai * 128 + m * 16];
#pragma unroll
        for (int ai = 0; ai < 2; ++ai)
#pragma unroll
            for (int m = 0; m < 4; ++m) { const int row = row0 + ai * 128 + m * 16; const float r = rr[ai][m]; bf16* rowp = O + (size_t)row * ldc + col0;
#pragma unroll
                for (int bj = 0; bj < 2; ++bj) { const pg8::i32x4 i0 = __builtin_bit_cast(pg8::i32x4, acc[ai][bj][m][0]), i1 = __builtin_bit_cast(pg8::i32x4, acc[ai][bj][m][1]);
                    u32x4 w; w.x = pg8::cvt_pk_bf16((float)i0[0] * r * c0[bj][0], (float)i0[1] * r * c0[bj][1]); w.y = pg8::cvt_pk_bf16((float)i0[2] * r * c0[bj][2], (float)i0[3] * r * c0[bj][3]);
                    w.z = pg8::cvt_pk_bf16((float)i1[0] * r * c1[bj][0], (float)i1[1] * r * c1[bj][1]); w.w = pg8::cvt_pk_bf16((float)i1[2] * r * c1[bj][2], (float)i1[3] * r * c1[bj][3]);
                    *(u32x4*)(rowp + bj * 128) = w; } }
    }
};
struct EpiPool {
    static constexpr bool PERM = true, I8 = false, PAIR64 = false;
    bf16* Y; const float* scale;
    __device__ __forceinline__ void operator()(AccRef acc, const Unit& u, int wr, int wc, int fr, int fq, const LAS int* rowsl) const {
        const int row0 = u.pm * 256 + wr * 64 + fr, col0 = u.aux * 256 + wc * 32 + 8 * fq;
        f32x4 sc[2][2];
#pragma unroll
        for (int bj = 0; bj < 2; ++bj) { sc[bj][0] = *(const f32x4*)(scale + col0 + bj * 128); sc[bj][1] = *(const f32x4*)(scale + col0 + bj * 128 + 4); }
#pragma unroll
        for (int ai = 0; ai < 2; ++ai)
#pragma unroll
            for (int m = 0; m < 4; ++m) { bf16* rowp = Y + (size_t)(row0 + ai * 128 + m * 16) * 4096 + 3072 + col0;
#pragma unroll
                for (int bj = 0; bj < 2; ++bj) { const f32x4 v0 = acc[ai][bj][m][0] * sc[bj][0], v1 = acc[ai][bj][m][1] * sc[bj][1];
                    u32x4 w; w.x = pg8::cvt_pk_bf16(v0[0], v0[1]); w.y = pg8::cvt_pk_bf16(v0[2], v0[3]); w.z = pg8::cvt_pk_bf16(v1[0], v1[1]); w.w = pg8::cvt_pk_bf16(v1[2], v1[3]);
                    *(u32x4*)(rowp + bj * 128) = w; } }
    }
};
struct EpiMerge {
    static constexpr bool PERM = true, I8 = false, PAIR64 = false;
    const bf16* proj; bf16* scr; bf16* merged;
    __device__ __forceinline__ void operator()(AccRef acc, const Unit& u, int wr, int wc, int fr, int fq, const LAS int* rowsl) const {
        const int seg = u.aux; const int gcol = C_GA + seg * 4096;
        const int row0 = u.pm * 256 + wr * 64 + fr, col0 = u.pn * 256 + wc * 32 + 8 * fq;
#pragma unroll
        for (int ai = 0; ai < 2; ++ai)
#pragma unroll
            for (int m = 0; m < 4; ++m) { const size_t row = (size_t)(row0 + ai * 128 + m * 16);
#pragma unroll
                for (int bj = 0; bj < 2; ++bj) { const int col = col0 + bj * 128;
                    const u32x4 gw = *(const u32x4*)(proj + row * PLD + gcol + col);
                    f32x4 v0 = acc[ai][bj][m][0], v1 = acc[ai][bj][m][1];
                    v0[0] *= sigmoidf_(bflo(gw.x)); v0[1] *= sigmoidf_(bfhi(gw.x)); v0[2] *= sigmoidf_(bflo(gw.y)); v0[3] *= sigmoidf_(bfhi(gw.y));
                    v1[0] *= sigmoidf_(bflo(gw.z)); v1[1] *= sigmoidf_(bfhi(gw.z)); v1[2] *= sigmoidf_(bflo(gw.w)); v1[3] *= sigmoidf_(bfhi(gw.w));
                    bf16* sp = scr + row * 4096 + col;
                    if (seg > 0) { const u32x4 pw = *(const u32x4*)sp; v0 = v0 + (f32x4){bflo(pw.x), bfhi(pw.x), bflo(pw.y), bfhi(pw.y)}; v1 = v1 + (f32x4){bflo(pw.z), bfhi(pw.z), bflo(pw.w), bfhi(pw.w)}; }
                    if (seg < 2) { u32x4 w; w.x = pg8::cvt_pk_bf16(v0[0], v0[1]); w.y = pg8::cvt_pk_bf16(v0[2], v0[3]); w.z = pg8::cvt_pk_bf16(v1[0], v1[1]); w.w = pg8::cvt_pk_bf16(v1[2], v1[3]); *(u32x4*)sp = w; }
                    else { u32x4 w; w.x = pg8::cvt_pk_bf16(v0[0], v0[1]); w.y = pg8::cvt_pk_bf16(v0[2], v0[3]); w.z = pg8::cvt_pk_bf16(v1[0], v1[1]); w.w = pg8::cvt_pk_bf16(v1[2], v1[3]);
                        *(u32x4*)(merged + row * 4096 + col) = w; } } }
    }
};
struct SchedMerge8 {
    pg8::TileOrder T; int G, c; const char* A; const char* B;
    __device__ __forceinline__ bool next(int i, Unit& u) const {
        const int ti = i / 3, seg = i - 3 * ti; int pm, pn; if (!T.tile((long)ti * G + c, pm, pn)) return false;
        const size_t koff = seg == 0 ? 0 : (seg == 1 ? 2048 : 3072);
        u.A = A + (size_t)pm * 256 * 4096 + koff; u.B = B + (size_t)pn * 256 * W8LD + koff; u.rows = nullptr; u.nt = seg == 0 ? 16 : 8; u.epi = 1; u.pm = pm; u.pn = pn; u.aux = seg;
        u.nvalid = 256; u.rowbase = pm * 256; u.shift = 0; return true;
    }
};
struct EpiMerge8 {
    static constexpr bool PERM = true, I8 = true, PAIR64 = false;
    const bf16* proj; bf16* scr; bf16* merged; const float* rs; const float* cs;
    __device__ __forceinline__ void operator()(AccRef acc, const Unit& u, int wr, int wc, int fr, int fq, const LAS int* rowsl) const {
        const int seg = u.aux; const int gcol = C_GA + seg * 4096;
        const int row0 = u.pm * 256 + wr * 64 + fr, col0 = u.pn * 256 + wc * 32 + 8 * fq;
        const float* rsv = rs + seg * 16384; const float* csv = cs + seg * 4096;
        f32x4 c0[2], c1[2];
#pragma unroll
        for (int bj = 0; bj < 2; ++bj) { c0[bj] = *(const f32x4*)(csv + col0 + bj * 128); c1[bj] = *(const f32x4*)(csv + col0 + bj * 128 + 4); }
#pragma unroll
        for (int aim = 0; aim < 4; ++aim) { const int ai = aim >> 1, mb = (aim & 1) * 2;
            u32x4 gw[4][2], pw[4][2]; float rr[4];
#pragma unroll
            for (int m = mb; m < mb + 2; ++m) { const size_t row = (size_t)(row0 + ai * 128 + m * 16); rr[m] = rsv[row];
#pragma unroll
                for (int bj = 0; bj < 2; ++bj) { const int col = col0 + bj * 128; gw[m][bj] = *(const u32x4*)(proj + row * PLD + gcol + col);
                    pw[m][bj] = seg > 0 ? *(const u32x4*)(scr + row * 4096 + col) : (u32x4){0u, 0u, 0u, 0u}; } }
#pragma unroll
            for (int m = mb; m < mb + 2; ++m) { const size_t row = (size_t)(row0 + ai * 128 + m * 16); const float r = rr[m];
#pragma unroll
                for (int bj = 0; bj < 2; ++bj) { const int col = col0 + bj * 128; const u32x4 g = gw[m][bj], pv = pw[m][bj];
                    const pg8::i32x4 i0 = __builtin_bit_cast(pg8::i32x4, acc[ai][bj][m][0]), i1 = __builtin_bit_cast(pg8::i32x4, acc[ai][bj][m][1]);
                    f32x4 v0 = (f32x4){(float)i0[0], (float)i0[1], (float)i0[2], (float)i0[3]} * c0[bj] * r, v1 = (f32x4){(float)i1[0], (float)i1[1], (float)i1[2], (float)i1[3]} * c1[bj] * r;
                    v0[0] *= sigmoidf_(bflo(g.x)); v0[1] *= sigmoidf_(bfhi(g.x)); v0[2] *= sigmoidf_(bflo(g.y)); v0[3] *= sigmoidf_(bfhi(g.y));
                    v1[0] *= sigmoidf_(bflo(g.z)); v1[1] *= sigmoidf_(bfhi(g.z)); v1[2] *= sigmoidf_(bflo(g.w)); v1[3] *= sigmoidf_(bfhi(g.w));
                    v0 = v0 + (f32x4){bflo(pv.x), bfhi(pv.x), bflo(pv.y), bfhi(pv.y)}; v1 = v1 + (f32x4){bflo(pv.z), bfhi(pv.z), bflo(pv.w), bfhi(pv.w)};
                    u32x4 w; w.x = pg8::cvt_pk_bf16(v0[0], v0[1]); w.y = pg8::cvt_pk_bf16(v0[2], v0[3]); w.z = pg8::cvt_pk_bf16(v1[0], v1[1]); w.w = pg8::cvt_pk_bf16(v1[2], v1[3]);
                    if (seg < 2) *(u32x4*)(scr + row * 4096 + col) = w; else *(u32x4*)(merged + row * 4096 + col) = w; } }
        }
    }
};
struct EpiRes8 {
    static constexpr bool PERM = true, I8 = true, PAIR64 = false;
    const bf16* h; bf16* out; const float* rs; const float* cs;
    __device__ __forceinline__ void operator()(AccRef acc, const Unit& u, int wr, int wc, int fr, int fq, const LAS int* rowsl) const {
        const int row0 = u.pm * 256 + wr * 64 + fr, col0 = u.pn * 256 + wc * 32 + 8 * fq;
        f32x4 c0[2], c1[2];
#pragma unroll
        for (int bj = 0; bj < 2; ++bj) { c0[bj] = *(const f32x4*)(cs + col0 + bj * 128); c1[bj] = *(const f32x4*)(cs + col0 + bj * 128 + 4); }
#pragma unroll
        for (int ai = 0; ai < 2; ++ai) {
            u32x4 hw[4][2]; float rr[4];
#pragma unroll
            for (int m = 0; m < 4; ++m) { const int row = row0 + ai * 128 + m * 16; rr[m] = rs[row];
#pragma unroll
                for (int bj = 0; bj < 2; ++bj) hw[m][bj] = *(const u32x4*)(h + (size_t)row * 4096 + col0 + bj * 128); }
#pragma unroll
            for (int m = 0; m < 4; ++m) { const int row = row0 + ai * 128 + m * 16; const float r = rr[m]; const size_t off = (size_t)row * 4096 + col0;
#pragma unroll
                for (int bj = 0; bj < 2; ++bj) { const u32x4 hv = hw[m][bj];
                    const pg8::i32x4 i0 = __builtin_bit_cast(pg8::i32x4, acc[ai][bj][m][0]), i1 = __builtin_bit_cast(pg8::i32x4, acc[ai][bj][m][1]);
                    const f32x4 v0 = (f32x4){bflo(hv.x), bfhi(hv.x), bflo(hv.y), bfhi(hv.y)} * DN_ALPHA + (f32x4){(float)i0[0], (float)i0[1], (float)i0[2], (float)i0[3]} * c0[bj] * r;
                    const f32x4 v1 = (f32x4){bflo(hv.z), bfhi(hv.z), bflo(hv.w), bfhi(hv.w)} * DN_ALPHA + (f32x4){(float)i1[0], (float)i1[1], (float)i1[2], (float)i1[3]} * c1[bj] * r;
                    u32x4 w; w.x = pg8::cvt_pk_bf16(v0[0], v0[1]); w.y = pg8::cvt_pk_bf16(v0[2], v0[3]); w.z = pg8::cvt_pk_bf16(v1[0], v1[1]); w.w = pg8::cvt_pk_bf16(v1[2], v1[3]);
                    *(u32x4*)(out + off + bj * 128) = w; } }
        }
    }
};
struct EpiResF32 {
    static constexpr bool PERM = true, I8 = false, PAIR64 = false;
    const bf16* h; bf16* out;
    __device__ __forceinline__ void operator()(AccRef acc, const Unit& u, int wr, int wc, int fr, int fq, const LAS int* rowsl) const {
        const int row0 = u.pm * 256 + wr * 64 + fr, col0 = u.pn * 256 + wc * 32 + 8 * fq;
#pragma unroll
        for (int ai = 0; ai < 2; ++ai) {
            u32x4 hws[4][2];
#pragma unroll
            for (int m = 0; m < 4; ++m)
#pragma unroll
                for (int bj = 0; bj < 2; ++bj) hws[m][bj] = *(const u32x4*)(h + (size_t)(row0 + ai * 128 + m * 16) * 4096 + col0 + bj * 128);
#pragma unroll
            for (int m = 0; m < 4; ++m) { const size_t off = (size_t)(row0 + ai * 128 + m * 16) * 4096 + col0;
#pragma unroll
                for (int bj = 0; bj < 2; ++bj) { const u32x4 hw = hws[m][bj];
                    const f32x4 v0 = (f32x4){bflo(hw.x), bfhi(hw.x), bflo(hw.y), bfhi(hw.y)} * DN_ALPHA + acc[ai][bj][m][0], v1 = (f32x4){bflo(hw.z), bfhi(hw.z), bflo(hw.w), bfhi(hw.w)} * DN_ALPHA + acc[ai][bj][m][1];
                    u32x4 w; w.x = pg8::cvt_pk_bf16(v0[0], v0[1]); w.y = pg8::cvt_pk_bf16(v0[2], v0[3]); w.z = pg8::cvt_pk_bf16(v1[0], v1[1]); w.w = pg8::cvt_pk_bf16(v1[2], v1[3]);
                    *(u32x4*)(out + off + bj * 128) = w; } }
        }
    }
};
struct EpiRouter {
    static constexpr bool PERM = false, I8 = false, PAIR64 = false;
    float* part;
    __device__ __forceinline__ void operator()(AccRef acc, const Unit& u, int wr, int wc, int fr, int fq, const LAS int* rowsl) const {
        if (wc >= 2) return;
        const int row0 = u.pm * 256 + wr * 64 + fr, col0 = wc * 32 + 4 * fq;
        float* base = part + (size_t)u.aux * NTOK * 64;
#pragma unroll
        for (int ai = 0; ai < 2; ++ai)
#pragma unroll
            for (int m = 0; m < 4; ++m)
#pragma unroll
                for (int n = 0; n < 2; ++n) *(f32x4*)(base + (size_t)(row0 + ai * 128 + m * 16) * 64 + col0 + n * 16) = acc[ai][0][m][n];
    }
};
struct EpiGLU {
    static constexpr bool PERM = true, I8 = false, PAIR64 = false;
    bf16* hd; bf16* hs; const float* pgate; const int* plist;
    __device__ __forceinline__ void operator()(AccRef acc, const Unit& u, int wr, int wc, int fr, int fq, const LAS int* rowsl) const {
        const bool moe = u.rows != nullptr;
        const float* gp = moe ? pgate + (u.rows - plist) : pgate;
        bf16* base = moe ? hd + (size_t)u.rowbase * 128 : hs + (size_t)u.rowbase * 256 + u.aux * 128;
        const int ld = moe ? 128 : 256;
        const int colw = wc * 32 + 8 * fq, rl = wr * 64 + fr;
#pragma unroll
        for (int ai = 0; ai < 2; ++ai)
#pragma unroll
            for (int m = 0; m < 4; ++m) { const int r = ai * 128 + m * 16 + rl;
                if (r < u.nvalid) {
                    const float gt = moe ? gp[r] : 1.f;
                    const f32x4 a0 = acc[ai][0][m][0], a1 = acc[ai][0][m][1], b0 = acc[ai][1][m][0], b1 = acc[ai][1][m][1];
                    u32x4 w;
                    w.x = pg8::cvt_pk_bf16(siluf_(a0[0]) * b0[0] * gt, siluf_(a0[1]) * b0[1] * gt); w.y = pg8::cvt_pk_bf16(siluf_(a0[2]) * b0[2] * gt, siluf_(a0[3]) * b0[3] * gt);
                    w.z = pg8::cvt_pk_bf16(siluf_(a1[0]) * b1[0] * gt, siluf_(a1[1]) * b1[1] * gt); w.w = pg8::cvt_pk_bf16(siluf_(a1[2]) * b1[2] * gt, siluf_(a1[3]) * b1[3] * gt);
                    *(u32x4*)(base + r * ld + colw) = w; } }
    }
};
struct EpiGLU8 {
    static constexpr bool PERM = true, I8 = true, PAIR64 = false;
    bf16* hd; bf16* hs; const float* pgate; const int* plist; const float* rs; const float* cs13; const float* css13;
    __device__ __forceinline__ void operator()(AccRef acc, const Unit& u, int wr, int wc, int fr, int fq, const LAS int* rowsl) const {
        const bool moe = u.rows != nullptr;
        const float* gp = moe ? pgate + (u.rows - plist) : pgate;
        bf16* base = moe ? hd + (size_t)u.rowbase * 128 : hs + (size_t)u.rowbase * 256 + u.aux * 128;
        const int ld = moe ? 128 : 256;
        const int colw = wc * 32 + 8 * fq, rl = wr * 64 + fr;
        const float* cb = moe ? cs13 + u.aux * 256 : css13 + u.aux * 256;
        const f32x4 c1a = *(const f32x4*)(cb + colw), c1b = *(const f32x4*)(cb + colw + 4), c3a = *(const f32x4*)(cb + 128 + colw), c3b = *(const f32x4*)(cb + 128 + colw + 4);
        float gts[2][4], rscs[2][4];
        {
            int tok[2][4];
#pragma unroll
            for (int ai = 0; ai < 2; ++ai)
#pragma unroll
                for (int m = 0; m < 4; ++m) { const int r = ai * 128 + m * 16 + rl; const int rc = r < u.nvalid ? r : 0;
                    tok[ai][m] = moe ? (u.rows[rc] >> 3) : (u.rowbase + rc); gts[ai][m] = moe ? gp[rc] : 1.f; }
#pragma unroll
            for (int ai = 0; ai < 2; ++ai)
#pragma unroll
                for (int m = 0; m < 4; ++m) rscs[ai][m] = rs[tok[ai][m]];
        }
#pragma unroll
        for (int ai = 0; ai < 2; ++ai)
#pragma unroll
            for (int m = 0; m < 4; ++m) { const int r = ai * 128 + m * 16 + rl;
                if (r < u.nvalid) {
                    const float gt = gts[ai][m];
                    const float rsc = rscs[ai][m];
                    const pg8::i32x4 a0 = __builtin_bit_cast(pg8::i32x4, acc[ai][0][m][0]), a1 = __builtin_bit_cast(pg8::i32x4, acc[ai][0][m][1]), b0 = __builtin_bit_cast(pg8::i32x4, acc[ai][1][m][0]), b1 = __builtin_bit_cast(pg8::i32x4, acc[ai][1][m][1]);
                    float o[8];
#pragma unroll
                    for (int e = 0; e < 4; ++e) { o[e] = siluf_((float)a0[e] * rsc * c1a[e]) * ((float)b0[e] * rsc * c3a[e]) * gt; o[4 + e] = siluf_((float)a1[e] * rsc * c1b[e]) * ((float)b1[e] * rsc * c3b[e]) * gt; }
                    u32x4 w; w.x = pg8::cvt_pk_bf16(o[0], o[1]); w.y = pg8::cvt_pk_bf16(o[2], o[3]); w.z = pg8::cvt_pk_bf16(o[4], o[5]); w.w = pg8::cvt_pk_bf16(o[6], o[7]);
                    *(u32x4*)(base + r * ld + colw) = w; } }
    }
};
struct EpiPair {
    static constexpr bool PERM = true, I8 = false, PAIR64 = true;
    signed char* yp;
    __device__ __forceinline__ void operator()(AccRef acc, const Unit& u, int wr, int wc, int fr, int fq, const LAS int* rowsl) const {
        const int colw = u.pn * 256 + wc * 64;
        const int col16 = colw + 16 * ((fq >> 1) + 2 * (fq & 1));
#pragma unroll
        for (int ai = 0; ai < 2; ++ai)
#pragma unroll
            for (int m = 0; m < 4; ++m) { const int r = ai * 128 + wr * 64 + m * 16 + fr;
                unsigned lo[2], hi[2];
#pragma unroll
                for (int bj = 0; bj < 2; ++bj) { const f32x4 v0 = acc[ai][bj][m][0] * 16.f, v1 = acc[ai][bj][m][1] * 16.f;
                    int a = 0, b = 0;
                    a = __builtin_amdgcn_cvt_pk_fp8_f32(v0[0], v0[1], a, false); a = __builtin_amdgcn_cvt_pk_fp8_f32(v0[2], v0[3], a, true);
                    b = __builtin_amdgcn_cvt_pk_fp8_f32(v1[0], v1[1], b, false); b = __builtin_amdgcn_cvt_pk_fp8_f32(v1[2], v1[3], b, true);
                    lo[bj] = (unsigned)a; hi[bj] = (unsigned)b; }
                const auto s0 = __builtin_amdgcn_permlane16_swap(lo[0], lo[1], false, false), s1 = __builtin_amdgcn_permlane16_swap(hi[0], hi[1], false, false);
                const u32x4 w = {s0[0], s1[0], s0[1], s1[1]};
                if (r < u.nvalid && yp) *(u32x4*)(yp + (size_t)rowsl[r] * 4096 + col16) = w; }
    }
};

__device__ __forceinline__ void ln_finish8(f32x4 (&v)[16], const f32x4 (&gv)[16], const f32x4 (&bv)[16], float* orow, bf16* brow, int lane, signed char* qrow = nullptr, float* qscale = nullptr) {
    float s1 = 0.f;
#pragma unroll
    for (int j = 0; j < 16; ++j) s1 += (v[j].x + v[j].y) + (v[j].z + v[j].w);
    const float mean = wave_sum(s1) * (1.f / DM); float s2 = 0.f;
#pragma unroll
    for (int j = 0; j < 16; ++j) { v[j] = v[j] - mean; s2 += (v[j].x * v[j].x + v[j].y * v[j].y) + (v[j].z * v[j].z + v[j].w * v[j].w); }
    const float rstd = 1.f / sqrtf(wave_sum(s2) * (1.f / DM) + LN_EPS);
    float amax = 0.f;
#pragma unroll
    for (int j = 0; j < 8; ++j) { const int c = 8 * (lane + 64 * j);
        const f32x4 o0 = v[2 * j] * rstd * gv[2 * j] + bv[2 * j], o1 = v[2 * j + 1] * rstd * gv[2 * j + 1] + bv[2 * j + 1];
        v[2 * j] = o0; v[2 * j + 1] = o1;
        amax = fmaxf(amax, fmaxf(fmaxf(fmaxf(fabsf(o0.x), fabsf(o0.y)), fmaxf(fabsf(o0.z), fabsf(o0.w))), fmaxf(fmaxf(fabsf(o1.x), fabsf(o1.y)), fmaxf(fabsf(o1.z), fabsf(o1.w)))));
        if (orow) { *(f32x4*)(orow + c) = o0; *(f32x4*)(orow + c + 4) = o1; }
        *(u32x4*)(brow + c) = (u32x4){pk2(o0.x, o0.y), pk2(o0.z, o0.w), pk2(o1.x, o1.y), pk2(o1.z, o1.w)}; }
    if (qrow) {
#pragma unroll
        for (int o = 1; o < 64; o <<= 1) amax = fmaxf(amax, __shfl_xor(amax, o));
        const float sc = fmaxf(amax, 1e-20f) * (1.f / 127.f), inv = 1.f / sc;
        if (lane == 0) *qscale = sc;
#pragma unroll
        for (int j = 0; j < 8; ++j) { const int c = 8 * (lane + 64 * j); const f32x4 a = v[2 * j] * inv, b = v[2 * j + 1] * inv;
            const unsigned lo = ((unsigned)(int)rintf(a.x) & 255u) | (((unsigned)(int)rintf(a.y) & 255u) << 8) | (((unsigned)(int)rintf(a.z) & 255u) << 16) | (((unsigned)(int)rintf(a.w) & 255u) << 24);
            const unsigned hi = ((unsigned)(int)rintf(b.x) & 255u) | (((unsigned)(int)rintf(b.y) & 255u) << 8) | (((unsigned)(int)rintf(b.z) & 255u) << 16) | (((unsigned)(int)rintf(b.w) & 255u) << 24);
            *(u32x2*)(qrow + c) = (u32x2){lo, hi}; }
    }
}
__device__ __forceinline__ void ln_finish8p(f32x4 (&v)[16], const float* g, const float* bta, float* orow, bf16* brow, int lane, signed char* qrow = nullptr, float* qscale = nullptr) {
    float s1 = 0.f;
#pragma unroll
    for (int j = 0; j < 16; ++j) s1 += (v[j].x + v[j].y) + (v[j].z + v[j].w);
    const float mean = wave_sum(s1) * (1.f / DM); float s2 = 0.f;
#pragma unroll
    for (int j = 0; j < 16; ++j) { v[j] = v[j] - mean; s2 += (v[j].x * v[j].x + v[j].y * v[j].y) + (v[j].z * v[j].z + v[j].w * v[j].w); }
    const float rstd = 1.f / sqrtf(wave_sum(s2) * (1.f / DM) + LN_EPS);
    float amax = 0.f;
#pragma unroll
    for (int hb2 = 0; hb2 < 2; ++hb2) {
        f32x4 gq[8], bq[8];
#pragma unroll
        for (int jj = 0; jj < 4; ++jj) { const int c = 8 * (lane + 64 * (4 * hb2 + jj)); gq[2 * jj] = *(const f32x4*)(g + c); gq[2 * jj + 1] = *(const f32x4*)(g + c + 4); bq[2 * jj] = *(const f32x4*)(bta + c); bq[2 * jj + 1] = *(const f32x4*)(bta + c + 4); }
#pragma unroll
        for (int jj = 0; jj < 4; ++jj) { const int j = 4 * hb2 + jj; const int c = 8 * (lane + 64 * j);
            const f32x4 o0 = v[2 * j] * rstd * gq[2 * jj] + bq[2 * jj], o1 = v[2 * j + 1] * rstd * gq[2 * jj + 1] + bq[2 * jj + 1];
            v[2 * j] = o0; v[2 * j + 1] = o1;
            amax = fmaxf(amax, fmaxf(fmaxf(fmaxf(fabsf(o0.x), fabsf(o0.y)), fmaxf(fabsf(o0.z), fabsf(o0.w))), fmaxf(fmaxf(fabsf(o1.x), fabsf(o1.y)), fmaxf(fabsf(o1.z), fabsf(o1.w)))));
            if (orow) { *(f32x4*)(orow + c) = o0; *(f32x4*)(orow + c + 4) = o1; }
            *(u32x4*)(brow + c) = (u32x4){pk2(o0.x, o0.y), pk2(o0.z, o0.w), pk2(o1.x, o1.y), pk2(o1.z, o1.w)}; }
    }
    if (qrow) {
#pragma unroll
        for (int o = 1; o < 64; o <<= 1) amax = fmaxf(amax, __shfl_xor(amax, o));
        const float sc = fmaxf(amax, 1e-20f) * (1.f / 127.f), inv = 1.f / sc;
        if (lane == 0) *qscale = sc;
#pragma unroll
        for (int j = 0; j < 8; ++j) { const int c = 8 * (lane + 64 * j); const f32x4 a = v[2 * j] * inv, b = v[2 * j + 1] * inv;
            const unsigned lo = ((unsigned)(int)rintf(a.x) & 255u) | (((unsigned)(int)rintf(a.y) & 255u) << 8) | (((unsigned)(int)rintf(a.z) & 255u) << 16) | (((unsigned)(int)rintf(a.w) & 255u) << 24);
            const unsigned hi = ((unsigned)(int)rintf(b.x) & 255u) | (((unsigned)(int)rintf(b.y) & 255u) << 8) | (((unsigned)(int)rintf(b.z) & 255u) << 16) | (((unsigned)(int)rintf(b.w) & 255u) << 24);
            *(u32x2*)(qrow + c) = (u32x2){lo, hi}; }
    }
}
__device__ __forceinline__ void ld_gb8(f32x4 (&gv)[16], f32x4 (&bv)[16], const float* g, const float* bta, int lane) {
#pragma unroll
    for (int j = 0; j < 8; ++j) { const int c = 8 * (lane + 64 * j); gv[2 * j] = *(const f32x4*)(g + c); gv[2 * j + 1] = *(const f32x4*)(g + c + 4); bv[2 * j] = *(const f32x4*)(bta + c); bv[2 * j + 1] = *(const f32x4*)(bta + c + 4); }
}
__device__ __forceinline__ void ld_row8(f32x4 (&v)[16], const bf16* row, int lane) {
#pragma unroll
    for (int j = 0; j < 8; ++j) { const u32x4 w = *(const u32x4*)(row + 8 * (lane + 64 * j));
        v[2 * j] = (f32x4){bflo(w.x), bfhi(w.x), bflo(w.y), bfhi(w.y)}; v[2 * j + 1] = (f32x4){bflo(w.z), bfhi(w.z), bflo(w.w), bfhi(w.w)}; }
}
__device__ __forceinline__ void lnin_phase(Frame& F, const Args& A) {
    const float* x = (const float*)ain_(A, I_X); const int lane = F.lane;
    f32x4 gv[16], bv[16]; ld_gb8(gv, bv, (const float*)ain_(A, I_LNIN_G), (const float*)ain_(A, I_LNIN_B), lane);
    for (int m = F.gw; m < NTOK; m += F.NGW) {
        f32x4 v[16];
#pragma unroll
        for (int j = 0; j < 8; ++j) { const float* p = x + (size_t)m * DM + 8 * (lane + 64 * j); v[2 * j] = *(const f32x4*)p; v[2 * j + 1] = *(const f32x4*)(p + 4); }
        ln_finish8(v, gv, bv, nullptr, (bf16*)(F.ws + WS_HB) + (size_t)m * DM, lane, (signed char*)(F.ws + WS_HB8) + (size_t)m * DM, (float*)(F.ws + WS_HBS) + m);
    }
}
__device__ __forceinline__ void ln1_phase(Frame& F, const Args& A, int l) {
    const bf16* ypre = (const bf16*)(F.ws + WS_YPRE); const int lane = F.lane;
    f32x4 gv[16], bv[16]; ld_gb8(gv, bv, (const float*)ain_(A, I_LN1G) + (size_t)l * DM, (const float*)ain_(A, I_LN1B) + (size_t)l * DM, lane);
    for (int m = F.gw; m < NTOK; m += F.NGW) {
        f32x4 v[16];
        ld_row8(v, ypre + (size_t)m * DM, lane);
        ln_finish8(v, gv, bv, nullptr, (bf16*)(F.ws + WS_HB) + (size_t)m * DM, lane,
                   (signed char*)(F.ws + WS_HB8) + (size_t)m * DM, (float*)(F.ws + WS_HBS) + m);
    }
}
__device__ __forceinline__ void ln2_phase(Frame& F, const Args& A, int l) {
    const bf16* ypre = (const bf16*)(F.ws + WS_YPRE); const signed char* yp = (const signed char*)(F.ws + WS_YPAIR); const int lane = F.lane;
    const float* g = (const float*)ain_(A, I_LN2G) + (size_t)l * DM; const float* bta = (const float*)ain_(A, I_LN2B) + (size_t)l * DM;
    for (int m = F.gw; m < NTOK; m += F.NGW) {
        f32x4 v[16];
        ld_row8(v, ypre + (size_t)m * DM, lane);
#pragma unroll
        for (int s = 0; s < 8; ++s) { const signed char* pr = yp + ((size_t)m * 8 + s) * DM + 8 * lane;
#pragma unroll
            for (int j = 0; j < 8; ++j) { const u32x2 w = *(const u32x2*)(pr + 512 * j);
                v[2 * j] = v[2 * j] + (f32x4){__builtin_amdgcn_cvt_f32_fp8((int)w.x, 0), __builtin_amdgcn_cvt_f32_fp8((int)w.x, 1), __builtin_amdgcn_cvt_f32_fp8((int)w.x, 2), __builtin_amdgcn_cvt_f32_fp8((int)w.x, 3)} * 0.0625f;
                v[2 * j + 1] = v[2 * j + 1] + (f32x4){__builtin_amdgcn_cvt_f32_fp8((int)w.y, 0), __builtin_amdgcn_cvt_f32_fp8((int)w.y, 1), __builtin_amdgcn_cvt_f32_fp8((int)w.y, 2), __builtin_amdgcn_cvt_f32_fp8((int)w.y, 3)} * 0.0625f; } }
        ln_finish8p(v, g, bta, l == DEPTH - 1 ? A.out + (size_t)m * DM : nullptr, (bf16*)(F.ws + WS_HB) + (size_t)m * DM, lane,
                   l == DEPTH - 1 ? nullptr : (signed char*)(F.ws + WS_HB8) + (size_t)m * DM, (float*)(F.ws + WS_HBS) + m);
    }
}
__device__ __forceinline__ void routing_phase(Frame& F, const Args& A, int l) {
    const float* part = (const float*)(F.ws + WS_LOGIT); const float* rb = (const float*)ain_(A, I_RB) + l * NEXP;
    int* plist = (int*)(F.ws + WS_PLIST); float* pgate = (float*)(F.ws + WS_PGS);
    unsigned* cnt = (unsigned*)(F.ctl + CW_CNT + l * 4096);
    const int lane = F.lane;
    const float bias = rb[lane];
    for (int m = F.gw; m < NTOK; m += F.NGW) {
        float lg = 0.f;
#pragma unroll
        for (int kq = 0; kq < 4; ++kq) lg += part[((size_t)kq * NTOK + m) * 64 + lane];
        const float score = sigmoidf_(lg), val = score + bias;
        const int rank = rank64(val, lane, (LAS float*)F.lds + F.wave * 64);
        const bool selb = rank < TOPK;
        const float ssum = wave_sum(selb ? score : 0.f);
        if (selb) {
            const unsigned pos = __hip_atomic_fetch_add(cnt + lane * 64, 1u, __ATOMIC_RELAXED, __HIP_MEMORY_SCOPE_AGENT);
            plist[(size_t)lane * PCAP + pos] = m * 8 + rank;
            pgate[(size_t)lane * PCAP + pos] = score / ssum * 2.5f;
        }
    }
}
__device__ __forceinline__ void moe_table(Frame& F, int l, volatile LAS int* tab) {
    __syncthreads();
    if (F.tid < 64) tab[65 + F.tid] = (int)__hip_atomic_load((unsigned*)(F.ctl + CW_CNT + l * 4096) + F.tid * 64, __ATOMIC_RELAXED, __HIP_MEMORY_SCOPE_AGENT);
    __syncthreads();
    if (F.tid == 0) { int s = 0; for (int e = 0; e < NEXP; ++e) { tab[e] = s; s += (tab[65 + e] + 255) >> 8; } tab[64] = s; }
    __syncthreads();
    if (F.tid < 64) { volatile LAS unsigned short* et2e = (volatile LAS unsigned short*)(tab + 132); const int t0 = tab[F.tid], t1 = tab[F.tid + 1]; for (int t = t0; t < t1; ++t) et2e[t] = (unsigned short)F.tid; }
    __syncthreads();
}

template <int KLEN>
__device__ __forceinline__ void quant_rows(Frame& F, const bf16* src, int ld, int koff, int nrows, signed char* dst, int ldd, float* sc_out) {
    const int lane = F.lane; constexpr int NJ = KLEN / 512;
    for (int n = F.gw; n < nrows; n += F.NGW) {
        f32x4 v[2 * NJ]; float amax = 0.f;
#pragma unroll
        for (int j = 0; j < NJ; ++j) { const u32x4 w = *(const u32x4*)(src + (size_t)n * ld + koff + 8 * (lane + 64 * j));
            v[2 * j] = (f32x4){bflo(w.x), bfhi(w.x), bflo(w.y), bfhi(w.y)}; v[2 * j + 1] = (f32x4){bflo(w.z), bfhi(w.z), bflo(w.w), bfhi(w.w)};
            amax = fmaxf(amax, fmaxf(fmaxf(fmaxf(fabsf(v[2 * j].x), fabsf(v[2 * j].y)), fmaxf(fabsf(v[2 * j].z), fabsf(v[2 * j].w))), fmaxf(fmaxf(fabsf(v[2 * j + 1].x), fabsf(v[2 * j + 1].y)), fmaxf(fabsf(v[2 * j + 1].z), fabsf(v[2 * j + 1].w))))); }
#pragma unroll
        for (int o = 1; o < 64; o <<= 1) amax = fmaxf(amax, __shfl_xor(amax, o));
        const float sc = fmaxf(amax, 1e-30f) * (1.f / 127.f), inv = 1.f / sc;
        if (lane == 0) sc_out[n] = sc;
#pragma unroll
        for (int j = 0; j < NJ; ++j) { const int c = 8 * (lane + 64 * j); const f32x4 a = v[2 * j] * inv, b = v[2 * j + 1] * inv;
            const unsigned lo = ((unsigned)(int)rintf(a.x) & 255u) | (((unsigned)(int)rintf(a.y) & 255u) << 8) | (((unsigned)(int)rintf(a.z) & 255u) << 16) | (((unsigned)(int)rintf(a.w) & 255u) << 24);
            const unsigned hi = ((unsigned)(int)rintf(b.x) & 255u) | (((unsigned)(int)rintf(b.y) & 255u) << 8) | (((unsigned)(int)rintf(b.z) & 255u) << 16) | (((unsigned)(int)rintf(b.w) & 255u) << 24);
            *(u32x2*)(dst + (size_t)n * ldd + koff + c) = (u32x2){lo, hi}; }
    }
}
__device__ __forceinline__ void quant_weights(Frame& F) {
    float* cs = (float*)(F.ws + WS_W8S);
    quant_rows<4096>(F, (const bf16*)(F.ws + WS_WIN), WLD, 0, PLD, (signed char*)(F.ws + WS_W8), W8LD, cs);
    quant_rows<4096>(F, (const bf16*)(F.ws + WS_W13), WLD, 0, NEXP * 256, (signed char*)(F.ws + WS_W138), W8LD, cs + 32768);
    quant_rows<4096>(F, (const bf16*)(F.ws + WS_WS13), WLD, 0, 512, (signed char*)(F.ws + WS_WS138), W8LD, cs + 65536);
    quant_rows<2048>(F, (const bf16*)(F.ws + WS_WUP), WLD, 0, 4096, (signed char*)(F.ws + WS_WUP8), W8LD, cs + 69632);
    quant_rows<1024>(F, (const bf16*)(F.ws + WS_WUP), WLD, 2048, 4096, (signed char*)(F.ws + WS_WUP8), W8LD, cs + 69632 + 4096);
    quant_rows<1024>(F, (const bf16*)(F.ws + WS_WUP), WLD, 3072, 4096, (signed char*)(F.ws + WS_WUP8), W8LD, cs + 69632 + 8192);
    quant_rows<4096>(F, (const bf16*)(F.ws + WS_WO), WLD, 0, 4096, (signed char*)(F.ws + WS_WO8), W8LD, cs + 81920);
}
__device__ __forceinline__ void quant_y(Frame& F) {
    float* rs = (float*)(F.ws + WS_HBS) + 16384;
    quant_rows<2048>(F, (const bf16*)(F.ws + WS_Y), 4096, 0, NTOK, (signed char*)(F.ws + WS_Y8), 4096, rs);
    quant_rows<1024>(F, (const bf16*)(F.ws + WS_Y), 4096, 2048, NTOK, (signed char*)(F.ws + WS_Y8), 4096, rs + 16384);
    quant_rows<1024>(F, (const bf16*)(F.ws + WS_Y), 4096, 3072, NTOK, (signed char*)(F.ws + WS_Y8), 4096, rs + 32768);
}
__device__ __forceinline__ void quant_merged(Frame& F) {
    quant_rows<4096>(F, (const bf16*)(F.ws + WS_MERGED), 4096, 0, NTOK, (signed char*)(F.ws + WS_M8), 4096, (float*)(F.ws + WS_HBS) + 65536);
}
#ifndef MK_ONE_LAUNCH
#define MK_ONE_LAUNCH 1
#endif
#ifndef MK_SP2
#define MK_SP2 true
#endif
#ifndef MK_REPEAT
#define MK_REPEAT 0
#endif
#define NREP(k) ((((MK_REPEAT) >> (k)) & 1) ? 2 : 1)
#ifndef MK_P0_NOSTORE
#define MK_P0_NOSTORE 0
#endif
#ifndef MK_SUBREP
#define MK_SUBREP 0
#endif
#ifndef MK_P1_ALLI8
#define MK_P1_ALLI8 0
#endif
#ifndef MK_HGRN_MMA
#define MK_HGRN_MMA 1
#endif
#ifndef MK_P12_NOSTORE
#define MK_P12_NOSTORE 0
#endif
#ifndef MK_PH_MASK
#define MK_PH_MASK 0x3fff
#endif
constexpr int NPH = 14;
constexpr int TAB_OFF = MISC_OFF + 128;

__device__ __forceinline__ void run_layer(Frame& F, const Args& args, const int l, const int lo, const int hi, const XcdBarrier& bar, volatile LAS int* tab,
                                          unsigned char* ws0, const int bid0, const int G0, const int wave0, const int vcu0) {
        const int pb = l * NPH;
        { int t_ = threadIdx.x; asm volatile("" : "+v"(t_)); F.tid = t_; F.lane = t_ & 63; }
        int bid = bid0, G = G0, wv_ = wave0, vc_ = vcu0; asm volatile("" : "+s"(bid), "+s"(G), "+s"(wv_), "+s"(vc_));
        F.wave = wv_; F.vcu = vc_; F.G = G; F.gw = vc_ * NWAVES + wv_; F.NGW = G * NWAVES;
        GAS unsigned char* wsg_ = (GAS unsigned char*)ws0; asm volatile("" : "+s"(wsg_)); unsigned char* ws = (unsigned char*)wsg_; F.ws = ws; F.ctl = (gu32*)(ws + WS_CTL);
#define IN(k) ((((MK_PH_MASK) >> (k)) & 1) && lo <= pb + (k) && pb + (k) < hi)
#define SEAM(k) do { if (IN(k) && pb + (k) + 1 < hi) xcd_barrier(bar); } while (0)
        if (IN(0)) for (int rep = 0; rep < NREP(0); ++rep) { if (rep) __syncthreads(); p0_phase(F, args, l, rep == 0 || !(MK_P0_NOSTORE)); if (l == 0) lnin_phase(F, args); }
        SEAM(0);
        if (IN(1)) for (int rep = 0; rep < NREP(1); ++rep) {
            if (rep) { __syncthreads(); int t_ = threadIdx.x; asm volatile("" : "+v"(t_)); F.tid = t_; F.lane = t_ & 63; }
            quant_weights(F);
            xcd_barrier(bar);
#if MK_P1_ALLI8
            {
                SchedTile S; S.T.init(64, PLD / 256); S.G = G; S.c = bid; S.A = (const char*)(ws + WS_HB8); S.B = (const char*)(ws + WS_W8); S.lda = 4096; S.ldb = W8LD; S.nt = 32;
                EpiStoreI8 E{(bf16*)(ws + WS_PROJ), PLD, (const float*)(ws + WS_HBS), (const float*)(ws + WS_W8S)};
                pg8::gemm_phase<EpiStoreI8, SchedTile, false, true, MK_SP2>(F.lds, 4096u, (unsigned)W8LD, S, E);
            }
        }
#else
            {
                SchedTile S; S.T.init(64, 48); S.G = G; S.c = bid; S.A = (const char*)(ws + WS_HB8); S.B = (const char*)(ws + WS_W8); S.lda = 4096; S.ldb = W8LD; S.nt = 32;
                EpiStoreI8 E{(bf16*)(ws + WS_PROJ) + C_GA, PLD, (const float*)(ws + WS_HBS), (const float*)(ws + WS_W8S)};
                pg8::gemm_phase<EpiStoreI8, SchedTile, false, true, MK_SP2>(F.lds, 4096u, (unsigned)W8LD, S, E);
            }
            __syncthreads();
            {
                SchedP1 S; S.T.init(64, 35); S.G = G; S.c = bid; S.A = (const char*)(ws + WS_HB); S.B = (const char*)(ws + WS_WIN);
                EpiStoreBf16 E{(bf16*)(ws + WS_PROJ), PLD};
                pg8::gemm_phase<EpiStoreBf16, SchedP1, false, true, MK_SP2>(F.lds, 8192u, (unsigned)(WLD * 2), S, E);
            }
        }
#endif
        SEAM(1);
        if (IN(2)) for (int rep = 0; rep < NREP(2); ++rep) {
            if (rep) { __syncthreads(); int t_ = threadIdx.x; asm volatile("" : "+v"(t_)); F.tid = t_; F.lane = t_ & 63; }
            for (int sr = 0; sr < ((MK_SUBREP & 1) ? 2 : 1); ++sr) { for (int u = bid; u < 256; u += G) { if (MK_HGRN_MMA) hgrn_unit_mma(F, args, l, u); else hgrn_unit(F, args, l, u); } __syncthreads(); }
            __syncthreads();
            for (int sr = 0; sr < ((MK_SUBREP & 2) ? 2 : 1); ++sr) { for (int u = bid; u < 256; u += G) compress_unit(F, u);
            for (int u = bid; u < 1024; u += G) vtrans_unit(F, u); }
            for (int sr = 0; sr < ((MK_SUBREP & 4) ? 2 : 1); ++sr) rope_pool_pass(F, rep == 0);
        }
        SEAM(2);
        if (IN(3)) for (int rep = 0; rep < NREP(3); ++rep) {
            if (rep) { __syncthreads(); int t_ = threadIdx.x; asm volatile("" : "+v"(t_)); F.tid = t_; F.lane = t_ & 63; }
#ifndef NO_CMP
            for (int sr = 0; sr < ((MK_SUBREP & 8) ? 2 : 1); ++sr) for (int u = bid; u < 2048; u += G) cmp_attn_item(F, u >> 8, (u >> 7) & 1, (u & 127) * 16 + 2 * F.wave, (LAS float*)F.lds + F.wave * 320);
#endif
            __syncthreads();
#ifndef NO_POOLG
            {
                SchedPool S{G, bid, (const char*)(ws + WS_MIXED), (const char*)(ws + WS_SMALL + SM_POOL)};
                EpiPool E{(bf16*)(ws + WS_Y), (const float*)ain_(args, I_POOLS) + (size_t)l * 1024};
                pg8::gemm_phase<EpiPool, SchedPool, false, true, MK_SP2>(F.lds, 2048u, 512u, S, E);
            }
#endif
#ifndef NO_FIN
            for (int sr = 0; sr < ((MK_SUBREP & 32) ? 2 : 1); ++sr) hgrn_finalize(F, args, l);
#endif
        }
        SEAM(3);
        if (IN(4)) for (int rep = 0; rep < NREP(4); ++rep) { for (int u = bid; u < 1024; u += G) win_attn_unit(F, u >> 7, (u >> 6) & 1, u & 63); __syncthreads(); }
        SEAM(4);
        if (IN(5)) for (int rep = 0; rep < NREP(5); ++rep) { { bf16x8 qfc[4]; unsigned long long mkc = 0ull; if (bid < 4096) sel_load(F, bid >> 9, (bid >> 8) & 1, (bid & 255) * 8 + F.wave, qfc, mkc);
              for (int u = bid; u < 4096; u += G) { const int un = u + G; sel_attn_item(F, u >> 9, (u >> 8) & 1, (u & 255) * 8 + F.wave, qfc, mkc, un < 4096, un >> 9, (un >> 8) & 1, (un & 255) * 8 + F.wave); } }
            xcd_barrier(bar); quant_y(F); }
        SEAM(5);
        if (IN(6)) for (int rep = 0; rep < NREP(6); ++rep) {
            if (rep) { __syncthreads(); int t_ = threadIdx.x; asm volatile("" : "+v"(t_)); F.tid = t_; F.lane = t_ & 63; }
            SchedMerge8 S; S.T.init(64, 16); S.G = G; S.c = bid; S.A = (const char*)(ws + WS_Y8); S.B = (const char*)(ws + WS_WUP8);
            EpiMerge8 E{(const bf16*)(ws + WS_PROJ), (bf16*)(ws + WS_YPRE), (bf16*)(ws + WS_MERGED), (const float*)(ws + WS_HBS) + 16384, (const float*)(ws + WS_W8S) + 69632};
            pg8::gemm_phase<EpiMerge8, SchedMerge8, false, true, MK_SP2>(F.lds, 4096u, (unsigned)W8LD, S, E);
            xcd_barrier(bar); quant_merged(F);
        }
        SEAM(6);
        if (IN(7)) for (int rep = 0; rep < NREP(7); ++rep) {
            if (rep) { __syncthreads(); int t_ = threadIdx.x; asm volatile("" : "+v"(t_)); F.tid = t_; F.lane = t_ & 63; }
            SchedTile S; S.T.init(64, 16); S.G = G; S.c = bid; S.A = (const char*)(ws + WS_M8); S.B = (const char*)(ws + WS_WO8); S.lda = 4096; S.ldb = W8LD; S.nt = 32;
            EpiRes8 E{(const bf16*)(ws + WS_HB), (bf16*)(ws + WS_YPRE), (const float*)(ws + WS_HBS) + 65536, (const float*)(ws + WS_W8S) + 81920};
            pg8::gemm_phase<EpiRes8, SchedTile, false, true, MK_SP2>(F.lds, 4096u, (unsigned)W8LD, S, E);
        }
        SEAM(7);
        if (IN(8)) for (int rep = 0; rep < NREP(8); ++rep) ln1_phase(F, args, l);
        SEAM(8);
        if (IN(9)) for (int rep = 0; rep < NREP(9); ++rep) {
            if (rep) { __syncthreads(); int t_ = threadIdx.x; asm volatile("" : "+v"(t_)); F.tid = t_; F.lane = t_ & 63; }
            SchedRouter S{G, bid, (const char*)(ws + WS_HB), (const char*)(ws + WS_ROUTER)};
            EpiRouter E{(float*)(ws + WS_LOGIT)};
            pg8::gemm_phase<EpiRouter, SchedRouter, false, true, MK_SP2>(F.lds, 8192u, (unsigned)(WLD * 2), S, E);
        }
        SEAM(9);
        if (IN(10)) routing_phase(F, args, l);
        SEAM(10);
        if (IN(11)) for (int rep = 0; rep < NREP(11); ++rep) {
            if (rep) { __syncthreads(); int t_ = threadIdx.x; asm volatile("" : "+v"(t_)); F.tid = t_; F.lane = t_ & 63; }
            moe_table(F, l, tab);
            SchedMoe1 S{G, bid, tab, (const char*)(ws + WS_HB8), (const char*)(ws + WS_W138), (const char*)(ws + WS_WS138), (const int*)(ws + WS_PLIST), W8LD, 32};
            EpiGLU8 E{(bf16*)(ws + WS_HD2), (bf16*)(ws + WS_HS), (const float*)(ws + WS_PGS), (const int*)(ws + WS_PLIST), (const float*)(ws + WS_HBS), (const float*)(ws + WS_W8S) + 32768, (const float*)(ws + WS_W8S) + 65536};
            pg8::gemm_phase<EpiGLU8, SchedMoe1, true, true, MK_SP2>(F.lds, 4096u, (unsigned)W8LD, S, E);
        }
        SEAM(11);
        if (IN(12)) for (int rep = 0; rep < NREP(12); ++rep) {
            if (rep) { __syncthreads(); int t_ = threadIdx.x; asm volatile("" : "+v"(t_)); F.tid = t_; F.lane = t_ & 63; }
            moe_table(F, l, tab);
#ifndef NO_MOE2
            {
                SchedMoe2 S{G, bid, tab, (const char*)(ws + WS_HD2), (const char*)(ws + WS_W2), (const int*)(ws + WS_PLIST)};
                EpiPair E{(MK_P12_NOSTORE && rep) ? (signed char*)nullptr : (signed char*)(ws + WS_YPAIR)};
                pg8::gemm_phase<EpiPair, SchedMoe2, false, true, MK_SP2, true>(F.lds, 256u, 256u, S, E);
            }
#endif
            __syncthreads();
#ifndef NO_SH2
            {
                SchedTile S; S.T.init(64, 16); S.G = G; S.c = bid; S.A = (const char*)(ws + WS_HS); S.B = (const char*)(ws + WS_WS2); S.lda = 512; S.ldb = 512; S.nt = 4;
                EpiResF32 E{(const bf16*)(ws + WS_HB), (bf16*)(ws + WS_YPRE)};
                pg8::gemm_phase<EpiResF32, SchedTile, false, true, MK_SP2>(F.lds, 512u, 512u, S, E);
            }
#endif
        }
        SEAM(12);
        if (IN(13)) for (int rep = 0; rep < NREP(13); ++rep) ln2_phase(F, args, l);
        if (IN(13) && pb + 14 < hi) __syncthreads();
#undef IN
#undef SEAM
}

__global__ void __launch_bounds__(NWAVES * 64, 2) mk_fwd(Args args) {
    extern __shared__ __attribute__((aligned(16))) unsigned char lds_raw[];
    Frame F;
    F.lds = (LAS unsigned char*)lds_raw;
    F.MISC = (volatile LAS unsigned*)(F.lds + MISC_OFF);
    F.tid = threadIdx.x; F.lane = F.tid & 63; F.wave = __builtin_amdgcn_readfirstlane(F.tid >> 6);
    F.G = gridDim.x; { const int bx = blockIdx.x; F.vcu = (F.G % 8 == 0) ? (bx % 8) * (F.G / 8) + bx / 8 : bx; }
    F.gw = F.vcu * NWAVES + F.wave; F.NGW = F.G * NWAVES;
    F.ws = args.ws; F.ctl = (gu32*)(args.ws + WS_CTL);
    const int bid0 = blockIdx.x, G0 = F.G, wave0 = F.wave, vcu0 = F.vcu;
    unsigned char* ws0 = args.ws;
    for (int u = F.tid; u < (LDS_BYTES - LDSCTL_OFF) / 4; u += NWAVES * 64) ((LAS unsigned*)(F.lds + LDSCTL_OFF))[u] = 0u;
    __syncthreads();
    const int lo = args.ph_lo, hi = args.ph_hi;
    XcdBarrier bar; bar.bar = (unsigned*)(F.ctl + CW_BAR); bar.x = 0; bar.st = nullptr;
    if (hi - lo > 1) bar = xcd_barrier_post((unsigned*)(F.ctl + CW_BAR), F.MISC + 8);
    volatile LAS int* tab = (volatile LAS int*)(F.lds + TAB_OFF);

    run_layer(F, args, 0, lo, hi, bar, tab, ws0, bid0, G0, wave0, vcu0);
    run_layer(F, args, 1, lo, hi, bar, tab, ws0, bid0, G0, wave0, vcu0);
}

extern "C" void kernel_launch(void* const* d_in, const int* in_sizes, int n_in, void* d_out, int out_size, void* d_ws, size_t ws_size, hipStream_t stream) {
    static int grid = 0;
    if (grid == 0) {
        if (n_in != 31 || out_size != NTOK * DM || ws_size < WS_END) { fprintf(stderr, "kernel_launch: unexpected shapes (n_in %d out %d ws %zu, need %zu)\n", n_in, out_size, ws_size, (size_t)WS_END); grid = -1; return; }
        int dev = 0, cus = 0, per_cu = 0;
        if (hipGetDevice(&dev) != hipSuccess || hipDeviceGetAttribute(&cus, hipDeviceAttributeMultiprocessorCount, dev) != hipSuccess) { grid = -1; return; }
        if (hipFuncSetAttribute((const void*)mk_fwd, hipFuncAttributeMaxDynamicSharedMemorySize, LDS_BYTES) != hipSuccess) { fprintf(stderr, "kernel_launch: hipFuncSetAttribute failed\n"); grid = -1; return; }
        if (hipOccupancyMaxActiveBlocksPerMultiprocessor(&per_cu, (const void*)mk_fwd, NWAVES * 64, LDS_BYTES) != hipSuccess || per_cu < 1)
            fprintf(stderr, "kernel_launch: occupancy query reports %d workgroups per CU\n", per_cu);
        (void)hipGetLastError();
        grid = cus;
    }
    if (grid < 0) return;
    if (hipMemsetAsync((char*)d_ws + WS_CTL, 0, CTL_ZERO_BYTES, stream) != hipSuccess) { fprintf(stderr, "kernel_launch: memset failed\n"); return; }
    Args a{};
    for (int i = 0; i < 31; ++i) a.in[i] = d_in[i];
    a.out = (float*)d_out; a.ws = (unsigned char*)d_ws;
#if MK_ONE_LAUNCH
    a.ph_lo = 0; a.ph_hi = DEPTH * NPH;
    hipLaunchKernelGGL(mk_fwd, dim3(grid), dim3(NWAVES * 64), LDS_BYTES, stream, a);
#else
    for (int p = 0; p < DEPTH * NPH; ++p) { a.ph_lo = p; a.ph_hi = p + 1; hipLaunchKernelGGL(mk_fwd, dim3(grid), dim3(NWAVES * 64), LDS_BYTES, stream, a); }
#endif
    const hipError_t le = hipPeekAtLastError();
    if (le != hipSuccess) fprintf(stderr, "kernel_launch: launch failed: %s\n", hipGetErrorName(le));
}
```

```cpp
#include <hip/hip_runtime.h>
#include <cstdio>
#include <cstdint>

#define GAS __attribute__((address_space(1)))
#define LAS __attribute__((address_space(3)))
typedef unsigned short bf16;
typedef unsigned u32x4 __attribute__((ext_vector_type(4)));
typedef unsigned u32x2 __attribute__((ext_vector_type(2)));
typedef float f32x4 __attribute__((ext_vector_type(4)));
typedef float f32x2 __attribute__((ext_vector_type(2)));
typedef short bf16x8 __attribute__((ext_vector_type(8)));
typedef GAS unsigned gu32;

#ifndef MK_P1_ALLI8
#define MK_P1_ALLI8 1
#endif
constexpr int NTOK = 16384, SEQ = 2048, BATCH = 8, DM = 4096, DEPTH = 2;
constexpr int PLD = 21248;
constexpr int NIN_SRC = 21040;
constexpr int C_Q = 0, C_KC = 2048, C_VC = 2304, C_KS = 2560, C_VS = 2816, C_KW = 3072, C_VW = 3328, C_HQ = 3584, C_HF = 4608, C_HI = 5632, C_HG = 6656,
              C_PIN = 7680, C_GA = 8704, C_GB = 12800, C_GC = 16896, C_AG = 20992;
constexpr int NEXP = 64, TOPK = 8, DEXP = 128, DSH = 256, NPAIR = NTOK * TOPK, PCAP = NTOK;
constexpr float LN_EPS = 1e-5f, RMS_EPS = 1e-6f;
constexpr float DN_ALPHA = 1.4142135623730951f;
constexpr float ATT_SCALE = 0.08838834764831845f;
constexpr float LOG2E = 1.4426950408889634f;

constexpr size_t MiB = 1u << 20;
constexpr size_t WS_CTL = 0, CTL_ZERO_BYTES = 1 * MiB;
constexpr int W8LD = 4224;
constexpr int WLD = 4160;
constexpr size_t WS_WIN = 1 * MiB, WS_WUP = 170 * MiB, WS_WO = 203 * MiB, WS_W13 = 236 * MiB, WS_W2 = 366 * MiB, WS_WS13 = 430 * MiB, WS_WS2 = 435 * MiB,
                 WS_CW1 = 437 * MiB, WS_SMALL = 440 * MiB, WS_ROUTER = 441 * MiB, WS_ROPE = 444 * MiB, WS_KCMP = 446 * MiB, WS_VST = 447 * MiB, WS_VWT = 455 * MiB,
                 WS_SEL = 463 * MiB, WS_LOGIT = 464 * MiB, WS_PLIST = 480 * MiB, WS_PGATE = 484 * MiB, WS_HD = 485 * MiB, WS_HS = 517 * MiB, WS_HB = 525 * MiB,
                 WS_YPRE = 653 * MiB, WS_PROJ = 909 * MiB, WS_QS = 1573 * MiB, WS_YAF = 1637 * MiB, WS_OHG = 1765 * MiB, WS_MIXED = 1829 * MiB, WS_Y = 1861 * MiB,
                 WS_MERGED = 1989 * MiB, WS_YAF2 = 2117 * MiB, WS_KST = 2245 * MiB, WS_KWT = 2253 * MiB, WS_PGS = 2261 * MiB, WS_HD2 = 2265 * MiB, WS_HB8 = 2305 * MiB, WS_HBS = 2419 * MiB, WS_W8S = 2420 * MiB, WS_W8 = 2421 * MiB, WS_W138 = 2507 * MiB, WS_WS138 = 2573 * MiB, WS_WUP8 = 2576 * MiB, WS_WO8 = 2593 * MiB, WS_END = 2610 * MiB;
constexpr size_t WS_OHG2 = WS_MERGED;
static_assert(WS_WIN + (size_t)PLD * WLD * 2 <= WS_WUP && WS_W13 + (size_t)NEXP * 256 * WLD * 2 <= WS_W2 && WS_WS13 + (size_t)512 * WLD * 2 <= WS_WS2 && WS_CW1 + (size_t)256 * WLD * 2 <= WS_SMALL && WS_ROUTER + (size_t)256 * WLD * 2 <= WS_ROPE && WS_WUP + (size_t)4096 * WLD * 2 <= WS_WO && WS_WO + (size_t)4096 * WLD * 2 <= WS_W13, "weight regions");
constexpr size_t WS_Y8 = WS_YAF, WS_M8 = WS_YAF2;
constexpr size_t WS_YPAIR = WS_PROJ;
static_assert(WS_YPAIR + (size_t)NPAIR * DM * 2 <= WS_END, "Ypair overlay");
static_assert(WS_PROJ + (size_t)NTOK * PLD * 2 == WS_QS, "proj size");
constexpr size_t SM_CW2 = 0, SM_POOL = 65536, SM_BIAS1 = 655360;
constexpr int CW_TMO = 0, CW_BAR = 4096, CW_CNT = 16384;

constexpr int RING_BYTES = 139264;
constexpr int LDSCTL_OFF = RING_BYTES, MISC_OFF = LDSCTL_OFF + 320;
constexpr int LDS_BYTES = 147456;
constexpr int NWAVES = 8;

#define LDS_WAIT() asm volatile("s_waitcnt lgkmcnt(0)" ::: "memory")
#define VM_WAIT() asm volatile("s_waitcnt vmcnt(0)" ::: "memory")
__device__ __forceinline__ unsigned f2bf(float f) { unsigned u = __builtin_bit_cast(unsigned, f); return (u + 0x7fffu + ((u >> 16) & 1u)) >> 16; }
__device__ __forceinline__ unsigned pk2(float lo, float hi) { return f2bf(lo) | (f2bf(hi) << 16); }
__device__ __forceinline__ float bflo(unsigned w) { return __uint_as_float(w << 16); }
__device__ __forceinline__ float bfhi(unsigned w) { return __uint_as_float(w & 0xffff0000u); }
__device__ __forceinline__ float bf1(bf16 b) { return __uint_as_float(((unsigned)b) << 16); }
__device__ __forceinline__ float sigmoidf_(float x) { return 1.0f / (1.0f + __expf(-x)); }
__device__ __forceinline__ float siluf_(float x) { return x / (1.0f + __expf(-x)); }
__device__ __forceinline__ float wave_sum(float v) {
#pragma unroll
    for (int o = 1; o < 64; o <<= 1) v += __shfl_xor(v, o);
    return v;
}
namespace pg8 {
#define PG8_LAS __attribute__((address_space(3)))
constexpr int BM = 256, BK = 64, HALF = 128, HTB = HALF * BK * 2  , STAGE_BYTES = 8 * HTB, NXCD = 8, WGM = 4;

__host__ __device__ __forceinline__ int lds_byte(int r, int c) { const int st = (r >> 4) * 2 + (c >> 5), rr = r & 15, cc = c & 31, ob = rr * 64 + cc * 2; return st * 1024 + (ob ^ (((ob >> 9) & 1) << 5)); }
__host__ __device__ __forceinline__ void stage_rc(int b, int& R, int& C) { const int st = b / 1024, sb = b % 1024, swz = sb ^ (((sb >> 9) & 1) << 5); R = (st >> 1) * 16 + swz / 64; C = (st & 1) * 32 + (swz % 64) / 2; }
__host__ __device__ __forceinline__ int perm32(int rho) { const int n = rho >> 4, i = rho & 15; return 8 * (i >> 2) + 4 * n + (i & 3); }

struct Unit {
    const char* A;
    const char* B;
    const int* rows;
    int nt;
    int epi;
    int pm, pn, aux;
    int nvalid, rowbase, shift;
};

struct TileOrder {
    int nM, nN, nwg;
    __device__ __forceinline__ void init(int nM_, int nN_) { nM = nM_; nN = nN_; nwg = nM * nN; }
    __device__ __forceinline__ bool tile(long L, int& pm, int& pn) const {
        if (L >= nwg) return false;
        int wgid = (int)L; { const int q = nwg / NXCD, r = nwg % NXCD, xcd = wgid % NXCD, off = wgid / NXCD; wgid = (xcd < r ? xcd * (q + 1) : r * (q + 1) + (xcd - r) * q) + off; }
        const int nig = WGM * nN, gid = wgid / nig, fm = gid * WGM, gsz = (nM - fm) < WGM ? (nM - fm) : WGM;
        pm = fm + ((wgid % nig) % gsz); pn = (wgid % nig) / gsz; return true;
    }
};

typedef int i32x4 __attribute__((ext_vector_type(4)));
template <bool I8> __device__ __forceinline__ f32x4 mma_sel(bf16x8 a, bf16x8 b, f32x4 c) {
    if constexpr (I8) return __builtin_bit_cast(f32x4, __builtin_amdgcn_mfma_i32_16x16x64_i8(__builtin_bit_cast(i32x4, a), __builtin_bit_cast(i32x4, b), __builtin_bit_cast(i32x4, c), 0, 0, 0));
    else return __builtin_amdgcn_mfma_f32_16x16x32_bf16(a, b, c, 0, 0, 0);
}
__device__ __forceinline__ unsigned cvt_pk_bf16(float lo, float hi) { unsigned r; asm volatile("v_cvt_pk_bf16_f32 %0, %1, %2" : "=v"(r) : "v"(lo), "v"(hi)); return r; }

template <class Epi, class Sched, bool GATHER, bool ALIGN_EPI, bool SP2, bool ROWS_LDS = false>
__device__ __forceinline__ void gemm_phase(PG8_LAS unsigned char* lds, const unsigned lda, const unsigned ldb, const Sched& S, const Epi& E) {
    int tid_ = threadIdx.x; asm volatile("" : "+v"(tid_));
    const int tid = tid_, wid = __builtin_amdgcn_readfirstlane(tid >> 6), lane = tid & 63, wr = wid >> 2, wc = wid & 3, fr = lane & 15, fq = lane >> 4;
    unsigned voffA[2], voffB[2]; int RA[2];
#pragma unroll
    for (int i = 0; i < 2; ++i) { int R, C; stage_rc(tid * 16 + i * 8192, R, C); const int Rb = Epi::PERM ? ((Epi::PAIR64 ? 64 * (R >> 5) : (R & ~31)) + perm32(R & 31)) : R;
        RA[i] = R; voffA[i] = GATHER ? (unsigned)(C * 2) : (unsigned)R * lda + (unsigned)(C * 2); voffB[i] = (unsigned)Rb * ldb + (unsigned)(C * 2); }
    const size_t kstep = (size_t)(BK * 2);
    const size_t hstepA = (size_t)HALF * lda, hstepB = (size_t)(Epi::PAIR64 ? 32 : HALF) * ldb;
    const unsigned ldsw = (unsigned)wid * 1024u;
    const int aoff = lds_byte(wr * 64 + fr, fq * 8), boff = lds_byte(wc * 32 + fr, fq * 8);
    unsigned gcur[2][2], gnxt[2][2];
#define PG8_SA(b, h) (((b) * 2 + (h)) * HTB)
#define PG8_SB(b, h) ((4 + (b) * 2 + (h)) * HTB)
#define PG8_STAGE_B(bufoff, gbase, h) do { _Pragma("unroll") for (int _i = 0; _i < 2; ++_i) \
        __builtin_amdgcn_global_load_lds((const unsigned*)((const char*)(gbase) + (size_t)(h) * hstepB + voffB[_i]), (PG8_LAS unsigned*)(lds + (bufoff) + ldsw + _i * 8192), 16, 0, 0); } while (0)
#define PG8_STAGE_A(bufoff, gbase, h) do { _Pragma("unroll") for (int _i = 0; _i < 2; ++_i) { \
        const char* _p = GATHER ? ((const char*)(gbase) + gcur[_i][h]) : ((const char*)(gbase) + (size_t)(h) * hstepA + voffA[_i]); \
        __builtin_amdgcn_global_load_lds((const unsigned*)_p, (PG8_LAS unsigned*)(lds + (bufoff) + ldsw + _i * 8192), 16, 0, 0); } } while (0)
#define PG8_GATHER_OFFS(dst, U) do { _Pragma("unroll") for (int _i = 0; _i < 2; ++_i) _Pragma("unroll") for (int _h = 0; _h < 2; ++_h) { \
        const int _r = RA[_i] + 128 * _h; int _idx; \
        if ((U).rows) { _idx = (U).rows[_r < (U).nvalid ? _r : 0] >> (U).shift; } else { _idx = (U).rowbase + _r; } \
        dst[_i][_h] = (unsigned)_idx * lda + voffA[_i]; } } while (0)
#define PG8_LDA(dst, b, h) do { _Pragma("unroll") for (int m = 0; m < 4; ++m) _Pragma("unroll") for (int k = 0; k < 2; ++k) dst[m][k] = *(const PG8_LAS bf16x8*)(lds + PG8_SA(b, h) + aoff + m * 2048 + k * 1024); } while (0)
#define PG8_LDB(dst, b, h) do { _Pragma("unroll") for (int n = 0; n < 2; ++n) _Pragma("unroll") for (int k = 0; k < 2; ++k) dst[n][k] = *(const PG8_LAS bf16x8*)(lds + PG8_SB(b, h) + boff + n * 2048 + k * 1024); } while (0)
#define PG8_MMA(ai, bj, At, Bt) do { __builtin_amdgcn_s_setprio(1); _Pragma("unroll") for (int m = 0; m < 4; ++m) _Pragma("unroll") for (int n = 0; n < 2; ++n) _Pragma("unroll") for (int k = 0; k < 2; ++k) \
        acc[ai][bj][m][n] = mma_sel<Epi::I8>(Bt[n][k], At[m][k], acc[ai][bj][m][n]); __builtin_amdgcn_s_setprio(0); } while (0)
#define PG8_WAIT_V(n) asm volatile("s_waitcnt vmcnt(" #n ")" ::: "memory")
#define PG8_WAIT_L(n) asm volatile("s_waitcnt lgkmcnt(" #n ")" ::: "memory")
#define PG8_BAR __builtin_amdgcn_s_barrier()
#define PG8_SCHED __builtin_amdgcn_sched_barrier(0)
    Unit cur, nxt; int ui = 0;
    if (!S.next(0, cur)) return;
    PG8_LAS int* rowbuf = (PG8_LAS int*)(lds + 131072); int nextrow = 0;
    if constexpr (ROWS_LDS) { if (tid < 256) rowbuf[tid] = cur.rows[tid < cur.nvalid ? tid : 0]; }
    f32x4 acc[2][2][4][2];
#pragma unroll
    for (int a = 0; a < 2; ++a)
#pragma unroll
        for (int b = 0; b < 2; ++b)
#pragma unroll
            for (int m = 0; m < 4; ++m)
#pragma unroll
                for (int n = 0; n < 2; ++n) acc[a][b][m][n] = (f32x4){0.f, 0.f, 0.f, 0.f};
    bf16x8 At[4][2], B0[2][2], B1[2][2];
    const char* cA = cur.A; const char* cB = cur.B;
    if constexpr (GATHER) { PG8_GATHER_OFFS(gcur, cur); }
    if constexpr (SP2) {
        PG8_STAGE_B(PG8_SB(0, 0), cB, 0); PG8_STAGE_B(PG8_SB(0, 1), cB, 1); PG8_STAGE_A(PG8_SA(0, 0), cA, 0); PG8_STAGE_A(PG8_SA(0, 1), cA, 1);
        if (wr == 1) PG8_BAR;
        PG8_WAIT_V(2); PG8_BAR;
        PG8_STAGE_B(PG8_SB(1, 0), cB + kstep, 0); PG8_STAGE_A(PG8_SA(1, 0), cA + kstep, 0); PG8_STAGE_B(PG8_SB(1, 1), cB + kstep, 1);
        PG8_WAIT_V(6); PG8_BAR;
    } else {
        PG8_STAGE_B(PG8_SB(0, 0), cB, 0); PG8_STAGE_A(PG8_SA(0, 0), cA, 0); PG8_STAGE_B(PG8_SB(0, 1), cB, 1); PG8_STAGE_A(PG8_SA(0, 1), cA, 1);
        if (wr == 1) PG8_BAR;
        PG8_WAIT_V(4); PG8_BAR;
        PG8_STAGE_B(PG8_SB(1, 0), cB + kstep, 0); PG8_STAGE_A(PG8_SA(1, 0), cA + kstep, 0); PG8_STAGE_B(PG8_SB(1, 1), cB + kstep, 1);
        PG8_WAIT_V(6); PG8_BAR;
    }
    for (;;) {
        const bool has_next = S.next(ui + 1, nxt);
        if constexpr (ROWS_LDS) { if (has_next && tid < 256) nextrow = nxt.rows[tid < nxt.nvalid ? tid : 0]; }
        const char* nA = has_next ? nxt.A : cA; const char* nB = has_next ? nxt.B : cB;
        if constexpr (GATHER) {
            if (has_next) { PG8_GATHER_OFFS(gnxt, nxt); }
            else {
#pragma unroll
                for (int i = 0; i < 2; ++i)
#pragma unroll
                    for (int h = 0; h < 2; ++h) gnxt[i][h] = gcur[i][h];
            }
        }
        int nt = cur.nt; asm volatile("" : "+s"(nt));
        for (int t = 0; t < nt; t += 2) {
            const bool last = (t == nt - 2);
            const char* a1 = cA + (size_t)(t + 1) * kstep;
            const char* a2 = last ? nA : cA + (size_t)(t + 2) * kstep; const char* b2 = last ? nB : cB + (size_t)(t + 2) * kstep;
            const char* a3 = a2 + kstep; const char* b3 = b2 + kstep;
            if constexpr (SP2) {
            PG8_LDB(B0, 0, 0); PG8_LDB(B1, 0, 1); PG8_SCHED; PG8_LDA(At, 0, 0); PG8_STAGE_A(PG8_SA(1, 1), a1, 1);
            if constexpr (GATHER) { if (last) {
#pragma unroll
                for (int i = 0; i < 2; ++i)
#pragma unroll
                    for (int h = 0; h < 2; ++h) gcur[i][h] = gnxt[i][h]; } }
            PG8_WAIT_V(8); PG8_WAIT_L(0); PG8_BAR; PG8_MMA(0, 0, At, B0); PG8_MMA(0, 1, At, B1); PG8_BAR; PG8_SCHED;
            PG8_LDA(At, 0, 1); PG8_STAGE_B(PG8_SB(0, 0), b2, 0); PG8_STAGE_B(PG8_SB(0, 1), b2, 1); PG8_STAGE_A(PG8_SA(0, 0), a2, 0);
            PG8_WAIT_V(8); PG8_WAIT_L(0); PG8_BAR; PG8_MMA(1, 0, At, B0); PG8_MMA(1, 1, At, B1); PG8_BAR; PG8_SCHED;
            PG8_LDB(B0, 1, 0); PG8_LDB(B1, 1, 1); PG8_SCHED; PG8_LDA(At, 1, 0); PG8_STAGE_A(PG8_SA(0, 1), a2, 1);
            PG8_WAIT_V(8); PG8_WAIT_L(0); PG8_BAR; PG8_MMA(0, 0, At, B0); PG8_MMA(0, 1, At, B1); PG8_BAR; PG8_SCHED;
            PG8_LDA(At, 1, 1); PG8_STAGE_B(PG8_SB(1, 0), b3, 0); PG8_STAGE_B(PG8_SB(1, 1), b3, 1); PG8_STAGE_A(PG8_SA(1, 0), a3, 0);
            PG8_WAIT_V(8); PG8_WAIT_L(0); PG8_BAR; PG8_MMA(1, 0, At, B0); PG8_MMA(1, 1, At, B1); PG8_BAR; PG8_SCHED;
            } else {
            PG8_LDB(B0, 0, 0); PG8_SCHED; PG8_LDA(At, 0, 0); PG8_STAGE_A(PG8_SA(1, 1), a1, 1);
            if constexpr (GATHER) { if (last) {
#pragma unroll
                for (int i = 0; i < 2; ++i)
#pragma unroll
                    for (int h = 0; h < 2; ++h) gcur[i][h] = gnxt[i][h]; } }
            PG8_WAIT_L(8); PG8_BAR; PG8_WAIT_L(0); PG8_MMA(0, 0, At, B0); PG8_BAR; PG8_SCHED;
            PG8_LDB(B1, 0, 1); PG8_STAGE_B(PG8_SB(0, 0), b2, 0);
            PG8_BAR; PG8_WAIT_L(0); PG8_MMA(0, 1, At, B1); PG8_BAR;
            PG8_LDA(At, 0, 1); PG8_STAGE_A(PG8_SA(0, 0), a2, 0);
            PG8_BAR; PG8_WAIT_L(0); PG8_MMA(1, 0, At, B0); PG8_BAR; PG8_SCHED;
            PG8_STAGE_B(PG8_SB(0, 1), b2, 1);
            PG8_WAIT_V(6); PG8_BAR; PG8_MMA(1, 1, At, B1); PG8_BAR;
            PG8_LDB(B0, 1, 0); PG8_SCHED; PG8_LDA(At, 1, 0); PG8_STAGE_A(PG8_SA(0, 1), a2, 1);
            PG8_WAIT_L(8); PG8_BAR; PG8_WAIT_L(0); PG8_MMA(0, 0, At, B0); PG8_BAR; PG8_SCHED;
            PG8_LDB(B1, 1, 1); PG8_STAGE_B(PG8_SB(1, 0), b3, 0);
            PG8_BAR; PG8_WAIT_L(0); PG8_MMA(0, 1, At, B1); PG8_BAR;
            PG8_LDA(At, 1, 1); PG8_STAGE_A(PG8_SA(1, 0), a3, 0);
            PG8_BAR; PG8_WAIT_L(0); PG8_MMA(1, 0, At, B0); PG8_BAR; PG8_SCHED;
            PG8_STAGE_B(PG8_SB(1, 1), b3, 1);
            PG8_WAIT_V(6); PG8_BAR; PG8_MMA(1, 1, At, B1); PG8_BAR;
            }
        }
        if constexpr (ROWS_LDS) { if (has_next && tid < 256) rowbuf[((ui + 1) & 1) * 256 + tid] = nextrow; }
        if (cur.epi) {
            if constexpr (ALIGN_EPI) { if (wr == 0) PG8_BAR; }
            E(acc, cur, wr, wc, fr, fq, (const PG8_LAS int*)(rowbuf + (ui & 1) * 256));
#pragma unroll
            for (int a = 0; a < 2; ++a)
#pragma unroll
                for (int b = 0; b < 2; ++b)
#pragma unroll
                    for (int m = 0; m < 4; ++m)
#pragma unroll
                        for (int n = 0; n < 2; ++n) acc[a][b][m][n] = (f32x4){0.f, 0.f, 0.f, 0.f};
        }
        if (!has_next) break;
        const int did_epi = cur.epi;
        cur = nxt; cA = nA; cB = nB; ++ui;
        if constexpr (ALIGN_EPI) { if (did_epi && wr == 1) PG8_BAR; }
    }
    PG8_WAIT_V(0);
    if constexpr (!ALIGN_EPI) { if (wr == 0) PG8_BAR; } else { if (!cur.epi && wr == 0) PG8_BAR; }
    PG8_BAR;
#undef PG8_SA
#undef PG8_SB
#undef PG8_STAGE_A
#undef PG8_STAGE_B
#undef PG8_GATHER_OFFS
#undef PG8_LDA
#undef PG8_LDB
#undef PG8_MMA
#undef PG8_WAIT_V
#undef PG8_WAIT_L
#undef PG8_BAR
#undef PG8_SCHED
}
}
#define XB_TMO      128
#define XB_XCNT(j)  (256  + 64 * (j))
#define XB_XSUB(j)  (1280 + 64 * (j))
#define XB_XGEN(j)  (2304 + 64 * (j))
#define XB_TOP      3328
#define XB_TOPGEN   3392
#define XCD_BAR_WORDS 3456
#define XB_SPIN_CAP (1u << 18)

__device__ __forceinline__ unsigned xb_ld(unsigned* p)              { return __hip_atomic_load(p, __ATOMIC_RELAXED, __HIP_MEMORY_SCOPE_AGENT); }
__device__ __forceinline__ unsigned xb_add(unsigned* p, unsigned v) { return __hip_atomic_fetch_add(p, v, __ATOMIC_RELAXED, __HIP_MEMORY_SCOPE_AGENT); }
__device__ __forceinline__ unsigned xb_xcc_id() { return (unsigned)__builtin_amdgcn_s_getreg((3 << 11) | 20) & 0xFu; }
#define XB_SPIN(cond, bar) do { unsigned _sp = 0; while (cond) { __builtin_amdgcn_s_sleep(1); \
    if ((++_sp & 255u) == 0u) { if (xb_ld(&(bar)[XB_TMO])) break; if (_sp > XB_SPIN_CAP) { atomicAdd(&(bar)[XB_TMO], 1u); break; } } } } while (0)

struct XcdBarrier {
    unsigned* bar; unsigned x;
    volatile LAS unsigned* st;
};

__device__ __forceinline__ XcdBarrier xcd_barrier_post(unsigned* bar, volatile LAS unsigned* st) {
    XcdBarrier b; b.bar = bar; b.x = xb_xcc_id(); b.st = st;
    if (threadIdx.x == 0) (void)xb_add(&bar[XB_XCNT(b.x)], 1u);
    return b;
}
__device__ __forceinline__ void xcd_barrier_complete(unsigned* bar, unsigned x, unsigned& nloc, unsigned& nx) {
    const unsigned G = gridDim.x * gridDim.y * gridDim.z;
    unsigned sum, cnt, mine, sp = 0u;
    for (;;) {
        sum = 0u; cnt = 0u; mine = 0u;
#pragma unroll
        for (unsigned j = 0; j < 16; ++j) { const unsigned c = xb_ld(&bar[XB_XCNT(j)]); sum += c; cnt += (c > 0u) ? 1u : 0u; mine = (j == x) ? c : mine; }
        if (sum == G) break;
        __builtin_amdgcn_s_sleep(1);
        if ((++sp & 255u) == 0u) { if (xb_ld(&bar[XB_TMO])) break; if (sp > XB_SPIN_CAP) { atomicAdd(&bar[XB_TMO], 1u); break; } }
    }
    nloc = mine > 0u ? mine : 1u; nx = cnt > 0u ? cnt : 1u;
}

__device__ __forceinline__ void xcd_barrier(const XcdBarrier& b) {
    asm volatile("s_waitcnt vmcnt(0)" ::: "memory");
    __syncthreads();
    if (threadIdx.x == 0) {
        unsigned* bar = b.bar;
        __builtin_amdgcn_s_waitcnt(0);
        unsigned nloc = b.st[0], nx = b.st[1];
        if (nloc == 0u) { xcd_barrier_complete(bar, b.x, nloc, nx); b.st[0] = nloc; b.st[1] = nx; }
        const unsigned old = xb_add(&bar[XB_XSUB(b.x)], 1u);
        const unsigned gen = old / nloc;
        if (old + 1u == (gen + 1u) * nloc) {
            __builtin_amdgcn_fence(__ATOMIC_RELEASE, "agent");
            asm volatile("s_waitcnt vmcnt(0)" ::: "memory");
            const unsigned og = xb_add(&bar[XB_TOP], 1u);
            const unsigned tg = og / nx;
            if (og + 1u == (tg + 1u) * nx) xb_add(&bar[XB_TOPGEN], 1u);
            else XB_SPIN(xb_ld(&bar[XB_TOPGEN]) == tg, bar);
            __builtin_amdgcn_fence(__ATOMIC_ACQUIRE, "agent");
            xb_add(&bar[XB_XGEN(b.x)], 1u);
            asm volatile("s_waitcnt vmcnt(0)" ::: "memory");
        } else {
            XB_SPIN(xb_ld(&bar[XB_XGEN(b.x)]) == gen, bar);
            __builtin_amdgcn_fence(__ATOMIC_ACQUIRE, "agent");
            asm volatile("s_waitcnt vmcnt(0)" ::: "memory");
        }
    }
    __syncthreads();
}

struct Args { const void* in[31]; float* out; unsigned char* ws; int ph_lo, ph_hi; };
enum { I_X = 0, I_POS, I_LNIN_G, I_LNIN_B, I_WIN, I_CPOSK, I_CPOSV, I_CW1K, I_CW2K, I_CW1V, I_CW2V, I_LBLOG, I_HGNG, I_POOLW, I_POOLS, I_WUA, I_WUH, I_WUP, I_WO,
       I_LN1G, I_LN1B, I_RW, I_RB, I_W1, I_W3, I_W2, I_WS1, I_WS3, I_WS2, I_LN2G, I_LN2B };

__device__ __forceinline__ const void* ain_(const Args& A, int i) { asm volatile("" : "+s"(i)); return (const void*)(const GAS void*)A.in[i]; }

struct Frame {
    LAS unsigned char* lds;
    volatile LAS unsigned* MISC;
    gu32* ctl;
    unsigned char* ws;
    int tid, lane, wave, vcu, G, gw, NGW;
};

__device__ __forceinline__ int p0_rowmap(int n, int mode, int rowoff) {
    if (mode == 1) return n < 3584 ? n : (n < 3632 ? C_AG + (n - 3584) : n - 48);
    if (mode == 2) return (n >> 7) * 256 + (n & 127) + rowoff;
    return n + rowoff;
}
__device__ __forceinline__ void p0_item(const float* W, int N, bf16* dst, int ldd, int coff, int mode, int rowoff, LAS float* scr, int kb, int nb, int lane, bool dostore = true) {
    const int k0 = 64 * kb, n0 = 64 * nb;
    const int r4 = lane >> 4, c4 = (lane & 15) * 4;
    const bool nok = n0 + c4 < N;
    f32x4 v[16];
#pragma unroll
    for (int i = 0; i < 16; ++i) v[i] = nok ? __builtin_nontemporal_load((const f32x4*)(W + (size_t)(k0 + 4 * i + r4) * N + n0 + c4)) : (f32x4){0.f, 0.f, 0.f, 0.f};
#pragma unroll
    for (int i = 0; i < 16; ++i) { LAS float* d = scr + (4 * i + r4) * 65 + c4; d[0] = v[i].x; d[1] = v[i].y; d[2] = v[i].z; d[3] = v[i].w; }
    LDS_WAIT(); asm volatile("" ::: "memory");
    const int kc = lane & 7;
#pragma unroll
    for (int j = 0; j < 8; ++j) { const int n = (lane >> 3) + 8 * j; const LAS float* sp = scr + (8 * kc) * 65 + n;
        u32x4 o; o.x = pk2(sp[0 * 65], sp[1 * 65]); o.y = pk2(sp[2 * 65], sp[3 * 65]); o.z = pk2(sp[4 * 65], sp[5 * 65]); o.w = pk2(sp[6 * 65], sp[7 * 65]);
        if (n0 + n < N && dostore) __builtin_nontemporal_store(o, (u32x4*)(dst + (size_t)p0_rowmap(n0 + n, mode, rowoff) * ldd + coff + k0 + 8 * kc)); }
    LDS_WAIT(); asm volatile("" ::: "memory");
}
__device__ __forceinline__ void p0_tile(const float* W, int K, int N, bf16* dst, int ldd, int coff, int mode, int rowoff, LAS unsigned* T, int kb, int nb, int wave, int lane, bool dostore) {
    const int k0 = 256 * kb, n0 = 256 * nb;
    const bool nok = n0 + 4 * lane < N;
#pragma unroll
    for (int half = 0; half < 2; ++half) {
        f32x4 v[16];
        const int kr = k0 + 32 * wave + 16 * half;
#pragma unroll
        for (int i = 0; i < 16; ++i) v[i] = (nok && kr + i < K && dostore) ? __builtin_nontemporal_load((const f32x4*)(W + (size_t)(kr + i) * N + n0 + 4 * lane)) : (f32x4){0.f, 0.f, 0.f, 0.f};
#pragma unroll
        for (int i = 0; i < 16; i += 2) { const int w = (32 * wave + 16 * half + i) >> 1;
#pragma unroll
            for (int e = 0; e < 4; ++e) T[(4 * lane + e) * 129 + w] = pk2(v[i][e], v[i + 1][e]); }
    }
    __syncthreads();
    const int rs = lane >> 5, c = lane & 31;
#pragma unroll 4
    for (int j = 0; j < 16; ++j) { const int n = 32 * wave + 2 * j + rs; const LAS unsigned* sp = T + n * 129 + 4 * c;
        const u32x4 o = {sp[0], sp[1], sp[2], sp[3]};
        if (n0 + n < N && k0 + 8 * c < K) __builtin_nontemporal_store(o, (u32x4*)(dst + (dostore ? (size_t)0 : (size_t)454 * MiB) + (size_t)p0_rowmap(n0 + n, mode, rowoff) * ldd + coff + k0 + 8 * c)); }
    __syncthreads();
}
__device__ __forceinline__ void ln_finish(f32x4 (&v)[16], const float* g, const float* b, float* orow, bf16* brow, int lane) {
    float s = 0.f;
#pragma unroll
    for (int j = 0; j < 16; ++j) s += (v[j].x + v[j].y) + (v[j].z + v[j].w);
    const float mean = wave_sum(s) * (1.f / DM); float s2 = 0.f;
#pragma unroll
    for (int j = 0; j < 16; ++j) { v[j] = v[j] - mean; s2 += (v[j].x * v[j].x + v[j].y * v[j].y) + (v[j].z * v[j].z + v[j].w * v[j].w); }
    const float rstd = 1.f / sqrtf(wave_sum(s2) * (1.f / DM) + LN_EPS);
#pragma unroll
    for (int j = 0; j < 16; ++j) { const int c = 4 * (lane + 64 * j);
        const f32x4 gg = *(const f32x4*)(g + c), bb = *(const f32x4*)(b + c);
        const f32x4 o = v[j] * rstd * gg + bb;
        if (orow) *(f32x4*)(orow + c) = o;
        u32x2 w; w.x = pk2(o.x, o.y); w.y = pk2(o.z, o.w); *(u32x2*)(brow + c) = w; }
}

__device__ __forceinline__ void p0_phase(Frame& F, const Args& A, int l, bool dostore = true) {
    LAS float* scr = (LAS float*)(F.lds + F.wave * 17408);
    unsigned char* ws = F.ws;
    const int gw = F.gw, NGW = F.NGW, lane = F.lane;
    if (gw < 256) {
        const int kv = gw >> 7, n = gw & 127;
        const float* pos = (const float*)ain_(A, kv ? I_CPOSV : I_CPOSK) + (size_t)l * 4096;
        const float* w1 = (const float*)ain_(A, kv ? I_CW1V : I_CW1K) + (size_t)l * 4096 * 128;
        float s = 0.f;
#pragma unroll 16
        for (int i = 0; i < 64; ++i) { const int k = lane + 64 * i; s += pos[k] * w1[(size_t)k * 128 + n]; }
        s = wave_sum(s);
        if (lane == 0) ((float*)(ws + WS_SMALL + SM_BIAS1))[kv * 128 + n] = s;
    }
    {
        u32x4 z = {0u, 0u, 0u, 0u};
        u32x4* p1 = (u32x4*)(ws + WS_WIN + (size_t)NIN_SRC * WLD * 2); const int n1 = (PLD - NIN_SRC) * WLD * 2 / 16;
        for (int i = gw * 64 + lane; i < n1; i += NGW * 64) p1[i] = z;
        u32x4* p2 = (u32x4*)(ws + WS_ROUTER + (size_t)64 * WLD * 2); const int n2 = 192 * WLD * 2 / 16;
        for (int i = gw * 64 + lane; i < n2; i += NGW * 64) p2[i] = z;
    }
    {
        LAS unsigned* T = (LAS unsigned*)F.lds;
        const int wave = F.wave, bidv = F.vcu, Gv = F.G;
        int rot = 0;
#define P0_JOB(NJ, ...) do { const int g0_ = (bidv + rot) % Gv; for (int r = g0_; r < (NJ); r += Gv) { __VA_ARGS__; } rot += (NJ); } while (0)
#define P0_T(W, K, N, DST, LDD, COFF, MODE, ROWOFF, KB, NB) p0_tile((W), (K), (N), (DST), (LDD), (COFF), (MODE), (ROWOFF), T, (KB), (NB), wave, lane, dostore)
        P0_JOB(16 * 83, P0_T((const float*)ain_(A, I_WIN) + (size_t)l * 4096 * NIN_SRC, 4096, NIN_SRC, (bf16*)(ws + WS_WIN), WLD, 0, 1, 0, r & 15, r >> 4));
        P0_JOB(8 * 16, P0_T((const float*)ain_(A, I_WUA) + (size_t)l * 2048 * 4096, 2048, 4096, (bf16*)(ws + WS_WUP), WLD, 0, 0, 0, r & 7, r >> 3));
        P0_JOB(4 * 16, P0_T((const float*)ain_(A, I_WUH) + (size_t)l * 1024 * 4096, 1024, 4096, (bf16*)(ws + WS_WUP), WLD, 2048, 0, 0, r & 3, r >> 2));
        P0_JOB(4 * 16, P0_T((const float*)ain_(A, I_WUP) + (size_t)l * 1024 * 4096, 1024, 4096, (bf16*)(ws + WS_WUP), WLD, 3072, 0, 0, r & 3, r >> 2));
        P0_JOB(16 * 16, P0_T((const float*)ain_(A, I_WO) + (size_t)l * 4096 * 4096, 4096, 4096, (bf16*)(ws + WS_WO), WLD, 0, 0, 0, r & 15, r >> 4));
        P0_JOB(64 * 16, const int e = r >> 4; P0_T((const float*)ain_(A, I_W1) + ((size_t)l * NEXP + e) * 4096 * 128, 4096, 128, (bf16*)(ws + WS_W13) + (size_t)e * 256 * WLD, WLD, 0, 0, 0, r & 15, 0));
        P0_JOB(64 * 16, const int e = r >> 4; P0_T((const float*)ain_(A, I_W3) + ((size_t)l * NEXP + e) * 4096 * 128, 4096, 128, (bf16*)(ws + WS_W13) + (size_t)e * 256 * WLD, WLD, 0, 0, 128, r & 15, 0));
        P0_JOB(64 * 16, const int e = r >> 4; P0_T((const float*)ain_(A, I_W2) + ((size_t)l * NEXP + e) * 128 * 4096, 128, 4096, (bf16*)(ws + WS_W2) + (size_t)e * 4096 * 128, 128, 0, 0, 0, 0, r & 15));
        P0_JOB(16, P0_T((const float*)ain_(A, I_WS1) + (size_t)l * 4096 * 256, 4096, 256, (bf16*)(ws + WS_WS13), WLD, 0, 2, 0, r, 0));
        P0_JOB(16, P0_T((const float*)ain_(A, I_WS3) + (size_t)l * 4096 * 256, 4096, 256, (bf16*)(ws + WS_WS13), WLD, 0, 2, 128, r, 0));
        P0_JOB(16, P0_T((const float*)ain_(A, I_WS2) + (size_t)l * 256 * 4096, 256, 4096, (bf16*)(ws + WS_WS2), 256, 0, 0, 0, 0, r));
        P0_JOB(16, P0_T((const float*)ain_(A, I_CW1K) + (size_t)l * 4096 * 128, 4096, 128, (bf16*)(ws + WS_CW1), WLD, 0, 0, 0, r, 0));
        P0_JOB(16, P0_T((const float*)ain_(A, I_CW1V) + (size_t)l * 4096 * 128, 4096, 128, (bf16*)(ws + WS_CW1) + 128 * WLD, WLD, 0, 0, 0, r, 0));
        P0_JOB(1, P0_T((const float*)ain_(A, I_CW2K) + (size_t)l * 128 * 128, 128, 128, (bf16*)(ws + WS_SMALL + SM_CW2), 128, 0, 0, 0, 0, 0));
        P0_JOB(1, P0_T((const float*)ain_(A, I_CW2V) + (size_t)l * 128 * 128, 128, 128, (bf16*)(ws + WS_SMALL + SM_CW2) + 128 * 128, 128, 0, 0, 0, 0, 0));
        P0_JOB(4, P0_T((const float*)ain_(A, I_POOLW) + ((size_t)l * 4 + r) * 256 * 256, 256, 256, (bf16*)(ws + WS_SMALL + SM_POOL) + (size_t)r * 256 * 256, 256, 0, 0, 0, 0, 0));
        P0_JOB(16, P0_T((const float*)ain_(A, I_RW) + (size_t)l * 4096 * 64, 4096, 64, (bf16*)(ws + WS_ROUTER), WLD, 0, 0, 0, r, 0));
#undef P0_T
#undef P0_JOB
    }
    if (l == 0) {
        const int* pos = (const int*)ain_(A, I_POS);
        float* rc = (float*)(ws + WS_ROPE); float* rs = rc + NTOK * 16;
        for (int i = gw * 64 + lane; i < NTOK * 16; i += NGW * 64) {
            const int m = i >> 4, k = i & 15;
            double invturn = 0.15915494309189535;
            for (int j = 0; j < k; ++j) invturn *= 0.44036660267178046;
            double tr = (double)pos[m] * invturn; tr -= (double)(long long)tr;
            const float fr = (float)tr;
            rc[i] = __builtin_amdgcn_cosf(fr); rs[i] = __builtin_amdgcn_sinf(fr);
        }
    }
}
__device__ __forceinline__ f32x4 mma16(bf16x8 a, bf16x8 b, f32x4 c) { return __builtin_amdgcn_mfma_f32_16x16x32_bf16(a, b, c, 0, 0, 0); }
__device__ __forceinline__ bf16x8 pack_p(f32x4 a, f32x4 b) {
    u32x4 w = {pg8::cvt_pk_bf16(a[0], a[1]), pg8::cvt_pk_bf16(a[2], a[3]), pg8::cvt_pk_bf16(b[0], b[1]), pg8::cvt_pk_bf16(b[2], b[3])};
    return __builtin_bit_cast(bf16x8, w);
}
__device__ __forceinline__ bf16x8 join8(u32x2 lo, u32x2 hi) { u32x4 w = {lo.x, lo.y, hi.x, hi.y}; return __builtin_bit_cast(bf16x8, w); }
__device__ __forceinline__ float max4(f32x4 v) { return fmaxf(fmaxf(v[0], v[1]), fmaxf(v[2], v[3])); }
__device__ __forceinline__ float sum4(f32x4 v) { return (v[0] + v[1]) + (v[2] + v[3]); }
__device__ __forceinline__ float swap16_other(float v, float& own) { auto rr = __builtin_amdgcn_permlane16_swap(__float_as_uint(v), __float_as_uint(v), false, false); own = __uint_as_float(rr[0]); return __uint_as_float(rr[1]); }
__device__ __forceinline__ float swap32_other(float v, float& own) { auto rr = __builtin_amdgcn_permlane32_swap(__float_as_uint(v), __float_as_uint(v), false, false); own = __uint_as_float(rr[0]); return __uint_as_float(rr[1]); }
__device__ __forceinline__ float xor_max_q(float v) { float a, b; b = swap16_other(v, a); v = fmaxf(a, b); b = swap32_other(v, a); return fmaxf(a, b); }
__device__ __forceinline__ float xor_sum_q(float v) { float a, b; b = swap16_other(v, a); v = a + b; b = swap32_other(v, a); return a + b; }
#define NEG_INF (-__builtin_inff())
__device__ __forceinline__ int kt_off(int key, int dim) { return (key >> 4) * 2048 + (dim >> 5) * 512 + (key & 15) * 32 + (dim & 31); }
__device__ __forceinline__ int vb_pos(int keyl) { return 8 * ((keyl & 15) >> 2) + 4 * ((keyl >> 4) & 1) + (keyl & 3); }
__device__ __forceinline__ int rank64(float val, int lane, LAS float* scr) {
    scr[lane] = val;
    LDS_WAIT(); asm volatile("" ::: "memory");
    int rank = 0;
#pragma unroll
    for (int j4 = 0; j4 < 16; ++j4) { const f32x4 v = *(const LAS f32x4*)(scr + 4 * j4);
#pragma unroll
        for (int e = 0; e < 4; ++e) { const int j = 4 * j4 + e; rank += (v[e] > val || (v[e] == val && j < lane)) ? 1 : 0; } }
    LDS_WAIT(); asm volatile("" ::: "memory");
    return rank;
}

__device__ __forceinline__ void hgrn_unit(Frame& F, const Args& A, int l, int u) {
    const int b = u >> 5, h = (u >> 2) & 7, vs = u & 3;
    LAS float* QF = (LAS float*)(F.lds);
    LAS float* FF = (LAS float*)(F.lds + 32768);
    LAS float* VV = (LAS float*)(F.lds + 65536);
    LAS float* PART = (LAS float*)(F.lds + 73728);
    LAS float* LB = (LAS float*)(F.lds + 106496);
    const bf16* proj = (const bf16*)(F.ws + WS_PROJ);
    float* ohg = (float*)(F.ws + WS_OHG);
    const int tid = F.tid, lane = F.lane, wave = F.wave;
    if (tid < 128) {
        float lb = 0.f;
        if (l == 1) { const float* lg = (const float*)ain_(A, I_LBLOG); lb = sigmoidf_(lg[1024 + h * 128 + tid] - lg[h * 128 + tid]); }
        LB[tid] = lb;
    }
    __syncthreads();
    const int tt = tid >> 4, c16 = tid & 15;
    const int tv = tid >> 2, pv = tid & 3;
    float lb8[8];
#pragma unroll
    for (int e = 0; e < 8; ++e) lb8[e] = LB[8 * c16 + e];
    const size_t rowb = (size_t)b * SEQ;
    u32x4 rq, rf, rv = {0u, 0u, 0u, 0u};
#define HG_LOAD(c) do { const bf16* pr = proj + (rowb + (c) * 32 + tt) * PLD; rq = *(const u32x4*)(pr + C_HQ + h * 128 + 8 * c16); rf = *(const u32x4*)(pr + C_HF + h * 128 + 8 * c16); \
        if (tid < 128) rv = *(const u32x4*)(proj + (rowb + (c) * 32 + tv) * PLD + C_HI + h * 128 + vs * 32 + 8 * pv); } while (0)
#define HG_STORE(buf) do { LAS float* qd = QF + (buf) * 4096 + tt * 128 + 8 * c16; LAS float* fd = FF + (buf) * 4096 + tt * 128 + 8 * c16; \
        const unsigned qw[4] = {rq.x, rq.y, rq.z, rq.w}, fw[4] = {rf.x, rf.y, rf.z, rf.w}; \
        _Pragma("unroll") for (int e = 0; e < 4; ++e) { qd[2 * e] = bflo(qw[e]); qd[2 * e + 1] = bfhi(qw[e]); \
            fd[2 * e] = lb8[2 * e] + (1.f - lb8[2 * e]) * sigmoidf_(bflo(fw[e])); fd[2 * e + 1] = lb8[2 * e + 1] + (1.f - lb8[2 * e + 1]) * sigmoidf_(bfhi(fw[e])); } \
        if (tid < 128) { LAS float* vd = VV + (buf) * 1024 + tv * 32 + 8 * pv; const unsigned vw[4] = {rv.x, rv.y, rv.z, rv.w}; \
            _Pragma("unroll") for (int e = 0; e < 4; ++e) { vd[2 * e] = bflo(vw[e]); vd[2 * e + 1] = bfhi(vw[e]); } } } while (0)
    HG_LOAD(0); HG_STORE(0);
    const int kg = tid >> 5, v = tid & 31;
    float S[8];
#pragma unroll
    for (int e = 0; e < 8; ++e) S[e] = 0.f;
    for (int c = 0; c < 64; ++c) {
        const int buf = c & 1;
        asm volatile("s_waitcnt lgkmcnt(0)\n\ts_barrier" ::: "memory");
        if (c + 1 < 64) HG_LOAD(c + 1);
        const LAS float* fp = FF + buf * 4096 + 8 * kg; const LAS float* qp = QF + buf * 4096 + 8 * kg; const LAS float* vp = VV + buf * 1024 + v;
#pragma unroll 1
        for (int t4 = 0; t4 < 32; t4 += 4) {
            f32x4 f0[4], f1[4], q0[4], q1[4]; float vv[4], po[4];
#pragma unroll
            for (int j = 0; j < 4; ++j) { const int t = t4 + j;
                f0[j] = *(const LAS f32x4*)(fp + t * 128); f1[j] = *(const LAS f32x4*)(fp + t * 128 + 4);
                q0[j] = *(const LAS f32x4*)(qp + t * 128); q1[j] = *(const LAS f32x4*)(qp + t * 128 + 4); vv[j] = vp[t * 32]; }
#pragma unroll
            for (int j = 0; j < 4; ++j) {
                float p = 0.f;
#pragma unroll
                for (int e = 0; e < 4; ++e) { S[e] = f0[j][e] * S[e] + (1.f - f0[j][e]) * vv[j]; p += q0[j][e] * S[e]; }
#pragma unroll
                for (int e = 0; e < 4; ++e) { S[4 + e] = f1[j][e] * S[4 + e] + (1.f - f1[j][e]) * vv[j]; p += q1[j][e] * S[4 + e]; }
                po[j] = p;
            }
#pragma unroll
            for (int j = 0; j < 4; ++j) { float a, b2; b2 = swap32_other(po[j], a); PART[(t4 + j) * 256 + wave * 32 + v] = a + b2; }
        }
        __syncthreads();
        {
            const int idx = tid * 2, t = idx >> 5, v2 = idx & 31;
            float s0 = 0.f, s1 = 0.f;
#pragma unroll
            for (int w = 0; w < 8; ++w) { const f32x2 p = *(const LAS f32x2*)(PART + t * 256 + w * 32 + v2); s0 += p.x; s1 += p.y; }
            *(f32x2*)(ohg + (rowb + c * 32 + t) * 1024 + h * 128 + vs * 32 + v2) = (f32x2){s0, s1};
        }
        if (c + 1 < 64) HG_STORE(buf ^ 1);
    }
    __syncthreads();
#undef HG_LOAD
#undef HG_STORE
}

__device__ __forceinline__ void hgrn_unit_mma(Frame& F, const Args& A, int l, int u) {
    const int b = u >> 5, h = (u >> 2) & 7, vs = u & 3;
    const int tid = F.tid, lane = F.lane, wave = F.wave, n = lane & 15, q = lane >> 4;
    const bf16* proj = (const bf16*)(F.ws + WS_PROJ);
    float* ohg = (float*)(F.ws + WS_OHG);
    LAS bf16* SCR = (LAS bf16*)(F.lds);
    LAS bf16* VT = (LAS bf16*)(F.lds + 65536);
    LAS float* DL = (LAS float*)(F.lds + 73728);
    LAS float* OP = (LAS float*)(F.lds + 77824);
    LAS float* LB = (LAS float*)(F.lds + 98304);
    __syncthreads();
    if (tid < 128) { float lb = 0.f; if (l == 1) { const float* lg = (const float*)ain_(A, I_LBLOG); lb = sigmoidf_(lg[1024 + h * 128 + tid] - lg[h * 128 + tid]); } LB[tid] = lb; }
    __syncthreads();
    const int kc = n, tq = q;
    float lb8[8];
#pragma unroll
    for (int e = 0; e < 8; ++e) lb8[e] = LB[8 * kc + e];
    const size_t rowb = (size_t)b * SEQ;
    const int nt = wave & 1, kq = wave >> 1;
    f32x4 S0 = {0.f, 0.f, 0.f, 0.f}, S1 = {0.f, 0.f, 0.f, 0.f};
    LAS bf16* scr = SCR + wave * 4096;
    u32x4 rf[4];
#define HGM_LOAD(mcx) do { const int tk_ = (mcx) * 128 + wave * 16; \
        _Pragma("unroll") for (int i = 0; i < 4; ++i) rf[i] = *(const u32x4*)(proj + (rowb + tk_ + 4 * tq + i) * PLD + C_HF + h * 128 + 8 * kc); } while (0)
    HGM_LOAD(0);
    for (int mc = 0; mc < 16; ++mc) {
        const int tok0 = mc * 128 + wave * 16;
        u32x4 rq[4];
#pragma unroll
        for (int i = 0; i < 4; ++i) rq[i] = *(const u32x4*)(proj + (rowb + tok0 + 4 * tq + i) * PLD + C_HQ + h * 128 + 8 * kc);
        const u32x4 rv = *(const u32x4*)(proj + (rowb + tok0 + (lane >> 2)) * PLD + C_HI + h * 128 + vs * 32 + 8 * (lane & 3));
        float fq_[4][8], kq_[4][8], bb[4][8];
#pragma unroll
        for (int i = 0; i < 4; ++i) {
            const unsigned qw[4] = {rq[i].x, rq[i].y, rq[i].z, rq[i].w}, fw[4] = {rf[i].x, rf[i].y, rf[i].z, rf[i].w};
#pragma unroll
            for (int e = 0; e < 8; ++e) {
                const float x = (e & 1) ? bfhi(fw[e >> 1]) : bflo(fw[e >> 1]);
                const float f = lb8[e] + (1.f - lb8[e]) * sigmoidf_(x);
                fq_[i][e] = (e & 1) ? bfhi(qw[e >> 1]) : bflo(qw[e >> 1]);
                kq_[i][e] = 1.f - f;
                const float lf = __builtin_amdgcn_logf(f);
                bb[i][e] = (i ? bb[i - 1][e] : 0.f) + lf;
            }
        }
        float tot[8], bref[8];
#pragma unroll
        for (int e = 0; e < 8; ++e) {
            const float x = bb[3][e];
            float a, b2;
            { auto rr = __builtin_amdgcn_permlane16_swap(__float_as_uint(x), __float_as_uint(x), false, false); a = __uint_as_float((tq & 1) ? rr[0] : rr[1]); }
            const float P = x + a;
            { auto rr = __builtin_amdgcn_permlane32_swap(__float_as_uint(P), __float_as_uint(P), false, false); b2 = __uint_as_float((tq & 2) ? rr[0] : rr[1]); }
            const float pre = ((tq & 1) ? a : 0.f) + ((tq & 2) ? b2 : 0.f);
            tot[e] = P + b2;
#pragma unroll
            for (int i = 0; i < 4; ++i) bb[i][e] += pre;
            bref[e] = __shfl(bb[3][e], kc + 16);
        }
#pragma unroll
        for (int i = 0; i < 4; ++i) {
            float km[8], qm[8];
#pragma unroll
            for (int e = 0; e < 8; ++e) { km[e] = kq_[i][e] * __builtin_amdgcn_exp2f(bref[e] - bb[i][e]); qm[e] = fq_[i][e] * __builtin_amdgcn_exp2f(bb[i][e] - bref[e]); }
            *(LAS u32x4*)(scr + (4 * tq + i) * 128 + 8 * kc) = (u32x4){pk2(km[0], km[1]), pk2(km[2], km[3]), pk2(km[4], km[5]), pk2(km[6], km[7])};
            *(LAS u32x4*)(scr + 2048 + (4 * tq + i) * 128 + 8 * kc) = (u32x4){pk2(qm[0], qm[1]), pk2(qm[2], qm[3]), pk2(qm[4], qm[5]), pk2(qm[6], qm[7])};
        }
        {
            const unsigned vw[4] = {rv.x, rv.y, rv.z, rv.w}; LAS bf16* vt = VT + wave * 512;
#pragma unroll
            for (int e = 0; e < 4; ++e) { vt[(8 * (lane & 3) + 2 * e) * 16 + (lane >> 2)] = (bf16)(vw[e] & 0xffffu); vt[(8 * (lane & 3) + 2 * e + 1) * 16 + (lane >> 2)] = (bf16)(vw[e] >> 16); }
        }
        LDS_WAIT(); asm volatile("" ::: "memory");
        f32x4 at = {0.f, 0.f, 0.f, 0.f};
#pragma unroll
        for (int ks = 0; ks < 4; ++ks) at = mma16(*(const LAS bf16x8*)(scr + n * 128 + 32 * ks + 8 * q), *(const LAS bf16x8*)(scr + 2048 + n * 128 + 32 * ks + 8 * q), at);
#pragma unroll
        for (int r = 0; r < 4; ++r) at[r] = (4 * q + r <= n) ? at[r] : 0.f;
        f32x4 oi[2];
        {
            const u32x4 aw = {pg8::cvt_pk_bf16(at[0], at[1]), pg8::cvt_pk_bf16(at[2], at[3]), 0u, 0u};
#pragma unroll
            for (int t2 = 0; t2 < 2; ++t2) { const u32x2 vv = *(const LAS u32x2*)(VT + wave * 512 + (16 * t2 + n) * 16 + 4 * q);
                oi[t2] = mma16(__builtin_bit_cast(bf16x8, aw), __builtin_bit_cast(bf16x8, (u32x4){vv.x, vv.y, 0u, 0u}), (f32x4){0.f, 0.f, 0.f, 0.f}); }
        }
        LDS_WAIT(); asm volatile("" ::: "memory");
#pragma unroll
        for (int i = 0; i < 4; ++i) {
            float qh[8];
#pragma unroll
            for (int e = 0; e < 8; ++e) qh[e] = fq_[i][e] * __builtin_amdgcn_exp2f(bb[i][e]);
            *(LAS u32x4*)(scr + (4 * tq + i) * 128 + 8 * kc) = (u32x4){pk2(qh[0], qh[1]), pk2(qh[2], qh[3]), pk2(qh[4], qh[5]), pk2(qh[6], qh[7])};
        }
#pragma unroll
        for (int e = 0; e < 8; ++e) {
            float kh[4];
#pragma unroll
            for (int i = 0; i < 4; ++i) kh[i] = kq_[i][e] * __builtin_amdgcn_exp2f(tot[e] - bb[i][e]);
            *(LAS u32x2*)(scr + 2048 + (8 * kc + e) * 16 + 4 * tq) = (u32x2){pk2(kh[0], kh[1]), pk2(kh[2], kh[3])};
        }
        if (tq == 0) {
            *(LAS f32x4*)(DL + wave * 128 + 8 * kc) = (f32x4){__builtin_amdgcn_exp2f(tot[0]), __builtin_amdgcn_exp2f(tot[1]), __builtin_amdgcn_exp2f(tot[2]), __builtin_amdgcn_exp2f(tot[3])};
            *(LAS f32x4*)(DL + wave * 128 + 8 * kc + 4) = (f32x4){__builtin_amdgcn_exp2f(tot[4]), __builtin_amdgcn_exp2f(tot[5]), __builtin_amdgcn_exp2f(tot[6]), __builtin_amdgcn_exp2f(tot[7])};
        }
        __builtin_amdgcn_sched_barrier(0);
        if (mc + 1 < 16) HGM_LOAD(mc + 1);
        __builtin_amdgcn_sched_barrier(0);
        asm volatile("s_waitcnt lgkmcnt(0)\n\ts_barrier" ::: "memory");
        for (int c = 0; c < 8; ++c) {
            const LAS bf16* qh = SCR + c * 4096; const LAS bf16* kht = qh + 2048; const int par = c & 1;
            {
                const u32x2 lo = *(const LAS u32x2*)(qh + n * 128 + 32 * kq + 4 * q), hi = *(const LAS u32x2*)(qh + n * 128 + 32 * kq + 16 + 4 * q);
                const u32x4 sw = {pg8::cvt_pk_bf16(S0[0], S0[1]), pg8::cvt_pk_bf16(S0[2], S0[3]), pg8::cvt_pk_bf16(S1[0], S1[1]), pg8::cvt_pk_bf16(S1[2], S1[3])};
                const f32x4 op = mma16(__builtin_bit_cast(bf16x8, (u32x4){lo.x, lo.y, hi.x, hi.y}), __builtin_bit_cast(bf16x8, sw), (f32x4){0.f, 0.f, 0.f, 0.f});
                LAS float* od = OP + par * 2560 + kq * 512 + 16 * nt + n;
#pragma unroll
                for (int r = 0; r < 4; ++r) od[(4 * q + r) * 32] = op[r];
                if (wave == c) { LAS float* oe = OP + par * 2560 + 4 * 512 + n;
#pragma unroll
                    for (int t2 = 0; t2 < 2; ++t2)
#pragma unroll
                        for (int r = 0; r < 4; ++r) oe[(4 * q + r) * 32 + 16 * t2] = oi[t2][r]; }
            }
            {
                const u32x4 z4 = {0u, 0u, 0u, 0u};
                const u32x4 vb = q < 2 ? *(const LAS u32x4*)(VT + c * 512 + (16 * nt + n) * 16 + 8 * q) : z4;
                const f32x4 d0 = *(const LAS f32x4*)(DL + c * 128 + 32 * kq + 4 * q), d1 = *(const LAS f32x4*)(DL + c * 128 + 32 * kq + 16 + 4 * q);
                const u32x4 ka0 = q < 2 ? *(const LAS u32x4*)(kht + (32 * kq + n) * 16 + 8 * q) : z4, ka1 = q < 2 ? *(const LAS u32x4*)(kht + (32 * kq + 16 + n) * 16 + 8 * q) : z4;
                S0 = mma16(__builtin_bit_cast(bf16x8, ka0), __builtin_bit_cast(bf16x8, vb), S0 * d0);
                S1 = mma16(__builtin_bit_cast(bf16x8, ka1), __builtin_bit_cast(bf16x8, vb), S1 * d1);
            }
            asm volatile("s_waitcnt lgkmcnt(0)\n\ts_barrier" ::: "memory");
            {
                const int t = tid >> 5, v = tid & 31; const LAS float* os = OP + par * 2560 + t * 32 + v;
                const float o = ((os[0] + os[512]) + (os[1024] + os[1536])) + os[2048];
                ohg[(rowb + mc * 128 + c * 16 + t) * 1024 + h * 128 + vs * 32 + v] = o;
            }
        }
        asm volatile("s_waitcnt lgkmcnt(0)\n\ts_barrier" ::: "memory");
    }
#undef HGM_LOAD
    __syncthreads();
}

__device__ __forceinline__ void compress_unit(Frame& F, int u) {
    const int kv = u >> 7, b = (u >> 4) & 7, g = (u >> 3) & 1, cg = u & 7;
    const int lane = F.lane, wave = F.wave, tid = F.tid, n = lane & 15, q = lane >> 4;
    const bf16* proj = (const bf16*)(F.ws + WS_PROJ);
    const bf16* w1t = (const bf16*)(F.ws + WS_CW1) + (size_t)kv * 128 * WLD;
    const bf16* w2t = (const bf16*)(F.ws + WS_SMALL + SM_CW2) + kv * 128 * 128;
    const float* bias1 = (const float*)(F.ws + WS_SMALL + SM_BIAS1) + kv * 128;
    LAS float* RED = (LAS float*)(F.lds);
    LAS bf16* HB = (LAS bf16*)(F.lds + 65536);
    const int csrc = (kv ? C_VC : C_KC) + g * 128;
    int cpos = 16 * cg + n; if (cpos > 126) cpos = 126;
    f32x4 acc[8];
#pragma unroll
    for (int nt = 0; nt < 8; ++nt) acc[nt] = (f32x4){0.f, 0.f, 0.f, 0.f};
    for (int jj = 0; jj < 4; ++jj) {
        const int j = wave * 4 + jj;
        const bf16* arow = proj + ((size_t)b * SEQ + 16 * cpos + j) * PLD + csrc + 8 * q;
#pragma unroll
        for (int ks = 0; ks < 4; ++ks) {
            const bf16x8 af = *(const bf16x8*)(arow + 32 * ks);
#pragma unroll
            for (int nt = 0; nt < 8; ++nt) {
                const bf16x8 bfr = *(const bf16x8*)(w1t + (size_t)(16 * nt + n) * WLD + j * 128 + 32 * ks + 8 * q);
                acc[nt] = mma16(af, bfr, acc[nt]);
            }
        }
    }
#pragma unroll
    for (int nt = 0; nt < 8; ++nt)
#pragma unroll
        for (int r = 0; r < 4; ++r) RED[wave * 2048 + (4 * q + r) * 128 + 16 * nt + n] = acc[nt][r];
    __syncthreads();
    {
        const int r = tid >> 5, c4 = (tid & 31) * 4;
        f32x4 s = *(const f32x4*)(bias1 + c4);
#pragma unroll
        for (int w = 0; w < 8; ++w) s = s + *(const LAS f32x4*)(RED + w * 2048 + r * 128 + c4);
        float o[4];
#pragma unroll
        for (int e = 0; e < 4; ++e) { const float x = s[e]; const float y = 0.7978845608028654f * (x + 0.044715f * x * x * x); const float th = 1.f - 2.f / (__expf(2.f * y) + 1.f); o[e] = 0.5f * x * (1.f + th); }
        *(LAS u32x2*)(HB + r * 136 + c4) = (u32x2){pk2(o[0], o[1]), pk2(o[2], o[3])};
    }
    __syncthreads();
    {
        f32x4 a2 = {0.f, 0.f, 0.f, 0.f};
#pragma unroll
        for (int ks = 0; ks < 4; ++ks) {
            const bf16x8 af = *(const LAS bf16x8*)(HB + n * 136 + 32 * ks + 8 * q);
            const bf16x8 bfr = *(const bf16x8*)(w2t + (16 * wave + n) * 128 + 32 * ks + 8 * q);
            a2 = mma16(af, bfr, a2);
        }
        const int dim = 16 * wave + n;
        if (kv == 0) {
            bf16* kc = (bf16*)(F.ws + WS_KCMP) + (size_t)(b * 2 + g) * 128 * 128;
#pragma unroll
            for (int r = 0; r < 4; ++r) { const int c = 16 * cg + 4 * q + r; kc[kt_off(c, dim)] = (bf16)(c < 127 ? f2bf(a2[r]) : 0u); }
        } else {
            bf16* vt = (bf16*)(F.ws + WS_KCMP + 524288) + (size_t)(b * 2 + g) * 128 * 128;
            float o[4];
#pragma unroll
            for (int r = 0; r < 4; ++r) o[r] = (16 * cg + 4 * q + r < 127) ? a2[r] : 0.f;
            *(u32x2*)(vt + (cg >> 1) * 4096 + dim * 32 + 8 * q + 4 * (cg & 1)) = (u32x2){pk2(o[0], o[1]), pk2(o[2], o[3])};
        }
    }
    __syncthreads();
}

__device__ __forceinline__ void vtrans_unit(Frame& F, int u) {
    const int br = u >> 9, b = (u >> 6) & 7, g = (u >> 5) & 1, tb = u & 31;
    const int tid = F.tid;
    const bf16* proj = (const bf16*)(F.ws + WS_PROJ);
    LAS bf16* T = (LAS bf16*)(F.lds);
    bf16* vT = (bf16*)(F.ws + (br ? WS_VWT : WS_VST)) + (size_t)(b * 2 + g) * 128 * SEQ;
    {
        const int tt = tid >> 3, part = tid & 7;
        const bf16* src = proj + ((size_t)b * SEQ + tb * 64 + tt) * PLD + (br ? C_VW : C_VS) + g * 128 + 16 * part;
        const u32x4 a = *(const u32x4*)src, c = *(const u32x4*)(src + 8);
        const unsigned w[8] = {a.x, a.y, a.z, a.w, c.x, c.y, c.z, c.w};
#pragma unroll
        for (int e = 0; e < 8; ++e) { T[(16 * part + 2 * e) * 72 + tt] = (bf16)(w[e] & 0xffffu); T[(16 * part + 2 * e + 1) * 72 + tt] = (bf16)(w[e] >> 16); }
    }
    __syncthreads();
    {
        const int d = tid >> 2, part = tid & 3, blkl = part >> 1, half = part & 1;
        unsigned w[8];
#pragma unroll
        for (int e = 0; e < 8; ++e) {
            const int p0 = 16 * half + 2 * e, p1 = p0 + 1;
            const int k0 = 16 * ((p0 >> 2) & 1) + 4 * (p0 >> 3) + (p0 & 3), k1 = 16 * ((p1 >> 2) & 1) + 4 * (p1 >> 3) + (p1 & 3);
            w[e] = (unsigned)T[d * 72 + 32 * blkl + k0] | ((unsigned)T[d * 72 + 32 * blkl + k1] << 16);
        }
        bf16* dst = vT + (size_t)(2 * tb + blkl) * 4096 + d * 32 + 16 * half;
        *(u32x4*)dst = (u32x4){w[0], w[1], w[2], w[3]}; *(u32x4*)(dst + 8) = (u32x4){w[4], w[5], w[6], w[7]};
    }
    __syncthreads();
}

__device__ __forceinline__ void rope_pair(const bf16* s1, const bf16* s2, bf16* d1, bf16* d2, const float* rc, const float* rs) {
    const u32x4 a = *(const u32x4*)s1, c = *(const u32x4*)s2;
    const f32x4 c0 = *(const f32x4*)rc, c1 = *(const f32x4*)(rc + 4), s0 = *(const f32x4*)rs, s1v = *(const f32x4*)(rs + 4);
    const unsigned aw[4] = {a.x, a.y, a.z, a.w}, cw[4] = {c.x, c.y, c.z, c.w};
    const float cs[8] = {c0[0], c0[1], c0[2], c0[3], c1[0], c1[1], c1[2], c1[3]}, sn[8] = {s0[0], s0[1], s0[2], s0[3], s1v[0], s1v[1], s1v[2], s1v[3]};
    unsigned o1[4], o2[4];
#pragma unroll
    for (int e = 0; e < 4; ++e) {
        const float x1l = bflo(aw[e]), x1h = bfhi(aw[e]), x2l = bflo(cw[e]), x2h = bfhi(cw[e]);
        o1[e] = pk2(x1l * cs[2 * e] - x2l * sn[2 * e], x1h * cs[2 * e + 1] - x2h * sn[2 * e + 1]);
        o2[e] = pk2(x2l * cs[2 * e] + x1l * sn[2 * e], x2h * cs[2 * e + 1] + x1h * sn[2 * e + 1]);
    }
    *(u32x4*)d1 = (u32x4){o1[0], o1[1], o1[2], o1[3]}; *(u32x4*)d2 = (u32x4){o2[0], o2[1], o2[2], o2[3]};
}
__device__ __forceinline__ void rope_pool_pass(Frame& F, bool do_krope) {
    bf16* proj = (bf16*)(F.ws + WS_PROJ); bf16* qs = (bf16*)(F.ws + WS_QS); bf16* mixed = (bf16*)(F.ws + WS_MIXED);
    const float* rc = (const float*)(F.ws + WS_ROPE); const float* rs = rc + NTOK * 16;
    const int gt = F.gw * 64 + F.lane, NT = F.NGW * 64;
    (void)do_krope;
    {
        constexpr int NQ = NTOK * 16 * 12, NK = NTOK * 4 * 12;
        for (int base = gt; base < NQ + NK; base += 4 * NT) {
            u32x4 v[4]; bf16* d[4];
#pragma unroll
            for (int k = 0; k < 4; ++k) { const int it = base + k * NT; d[k] = nullptr;
                if (it < NQ) { const int m = it / 192, r = it - m * 192, hd = r / 12, ch = 4 + (r - hd * 12);
                    v[k] = *(const u32x4*)(proj + (size_t)m * PLD + C_Q + hd * 128 + 8 * ch); d[k] = qs + (size_t)m * 2048 + hd * 128 + 8 * ch; }
                else if (it < NQ + NK) { const int i2 = it - NQ, m = i2 / 48, r = i2 - m * 48, bg = r / 12, ch = 4 + (r - bg * 12), br = bg >> 1, g = bg & 1;
                    v[k] = *(const u32x4*)(proj + (size_t)m * PLD + (br ? C_KW : C_KS) + g * 128 + 8 * ch);
                    d[k] = (bf16*)(F.ws + (br ? WS_KWT : WS_KST)) + (size_t)((m >> 11) * 2 + g) * SEQ * 128 + kt_off(m & (SEQ - 1), 8 * ch); } }
#pragma unroll
            for (int k = 0; k < 4; ++k) if (d[k]) *(u32x4*)d[k] = v[k];
        }
    }
    {
        constexpr int NQ = NTOK * 16 * 2, NK = NTOK * 4 * 2;
        for (int it = gt; it < NQ + NK; it += NT) {
            if (it < NQ) { const int m = it >> 5, hd = (it >> 1) & 15, ch = it & 1;
                const bf16* sp = proj + (size_t)m * PLD + C_Q + hd * 128 + 8 * ch; bf16* dp = qs + (size_t)m * 2048 + hd * 128 + 8 * ch;
                rope_pair(sp, sp + 16, dp, dp + 16, rc + m * 16 + 8 * ch, rs + m * 16 + 8 * ch); }
            else { const int i2 = it - NQ, m = i2 >> 3, bg = (i2 >> 1) & 3, ch = i2 & 1, br = bg >> 1, g = bg & 1;
                const bf16* sp = proj + (size_t)m * PLD + (br ? C_KW : C_KS) + g * 128 + 8 * ch;
                bf16* dp = (bf16*)(F.ws + (br ? WS_KWT : WS_KST)) + (size_t)((m >> 11) * 2 + g) * SEQ * 128 + kt_off(m & (SEQ - 1), 8 * ch);
                rope_pair(sp, sp + 16, dp, dp + 16, rc + m * 16 + 8 * ch, rs + m * 16 + 8 * ch); }
        }
    }
#define POOL_LOOP(GI, W) \
    for (int it = gt; it < NTOK * 32; it += NT) { \
        const int m = it >> 5, ch = (GI) * 32 + (it & 31), s = m & (SEQ - 1), cnt = (s + 1 < (W)) ? s + 1 : (W); \
        const bf16* p = proj + (size_t)m * PLD + C_PIN + 8 * ch; \
        u32x4 a[W]; \
        _Pragma("unroll") for (int j = 0; j < (W); ++j) a[j] = j < cnt ? *(const u32x4*)(p - (size_t)j * PLD) : (u32x4){0u, 0u, 0u, 0u}; \
        float acc[8]; \
        _Pragma("unroll") for (int e = 0; e < 8; ++e) acc[e] = 0.f; \
        _Pragma("unroll") for (int j = 0; j < (W); ++j) { const unsigned aw[4] = {a[j].x, a[j].y, a[j].z, a[j].w}; \
            _Pragma("unroll") for (int e = 0; e < 4; ++e) { acc[2 * e] += bflo(aw[e]); acc[2 * e + 1] += bfhi(aw[e]); } } \
        const float inv = 1.f / (float)cnt; const unsigned ow[4] = {a[0].x, a[0].y, a[0].z, a[0].w}; \
        u32x4 o; o.x = pk2(acc[0] * inv - bflo(ow[0]), acc[1] * inv - bfhi(ow[0])); o.y = pk2(acc[2] * inv - bflo(ow[1]), acc[3] * inv - bfhi(ow[1])); \
        o.z = pk2(acc[4] * inv - bflo(ow[2]), acc[5] * inv - bfhi(ow[2])); o.w = pk2(acc[6] * inv - bflo(ow[3]), acc[7] * inv - bfhi(ow[3])); \
        *(u32x4*)(mixed + (size_t)m * 1024 + 8 * ch) = o; }
    POOL_LOOP(0, 2) POOL_LOOP(1, 4) POOL_LOOP(2, 8) POOL_LOOP(3, 16)
#undef POOL_LOOP
}

__device__ __forceinline__ void cmp_attn_item(Frame& F, int b, int g, int tA, LAS float* PS) {
    const int lane = F.lane, n = lane & 15, q = lane >> 4, tp = n >> 3, head = g * 8 + (n & 7);
    const int s_tok = tA + tp; const size_t m = (size_t)b * SEQ + s_tok;
    const bf16* proj = (const bf16*)(F.ws + WS_PROJ);
    const bf16* kc = (const bf16*)(F.ws + WS_KCMP) + (size_t)(b * 2 + g) * 128 * 128;
    const bf16* vt = (const bf16*)(F.ws + WS_KCMP + 524288) + (size_t)(b * 2 + g) * 128 * 128;
    float* yaf = (float*)(F.ws + WS_YAF);
    bf16x8 qf[4];
#pragma unroll
    for (int ks = 0; ks < 4; ++ks) qf[ks] = *(const bf16x8*)(proj + m * PLD + C_Q + head * 128 + 32 * ks + 8 * q);
    const int tmax = tA + 1;
    const int nkt = tmax >= 31 ? (((tmax - 31) >> 4) >> 4) + 1 : 0;
    f32x4 p[8];
    float mx = -1e30f;
#pragma unroll
    for (int kt = 0; kt < 8; ++kt) {
        if (kt < nkt) {
            f32x4 a = {0.f, 0.f, 0.f, 0.f};
#pragma unroll
            for (int ks = 0; ks < 4; ++ks) { const bf16x8 kf = *(const bf16x8*)(kc + kt * 2048 + ks * 512 + n * 32 + 8 * q); a = mma16(kf, qf[ks], a); }
#pragma unroll
            for (int r = 0; r < 4; ++r) { const int c = 16 * kt + 4 * q + r; a[r] = (16 * c + 31 <= s_tok) ? a[r] * (ATT_SCALE * LOG2E) : NEG_INF; }
            p[kt] = a; mx = fmaxf(mx, max4(a));
        } else p[kt] = (f32x4){NEG_INF, NEG_INF, NEG_INF, NEG_INF};
    }
    mx = xor_max_q(mx);
    float l = 0.f;
#pragma unroll
    for (int kt = 0; kt < 8; ++kt) {
#pragma unroll
        for (int r = 0; r < 4; ++r) p[kt][r] = __builtin_amdgcn_exp2f(p[kt][r] - mx);
        l += sum4(p[kt]);
    }
    l = xor_sum_q(l);
    const float inv = l > 0.f ? 1.f / l : 0.f;
#pragma unroll
    for (int kt = 0; kt < 8; ++kt) {
        p[kt] = p[kt] * inv;
#pragma unroll
        for (int r = 0; r < 4; ++r) { float v = p[kt][r]; v += __shfl_xor(v, 1); v += __shfl_xor(v, 2); v += __shfl_xor(v, 4); if ((n & 7) == 0) PS[tp * 128 + 16 * kt + 4 * q + r] = v; }
    }
    f32x4 o[8];
#pragma unroll
    for (int nt = 0; nt < 8; ++nt) o[nt] = (f32x4){0.f, 0.f, 0.f, 0.f};
#pragma unroll
    for (int j = 0; j < 4; ++j) {
        if (2 * j < nkt) {
            const bf16x8 pb = pack_p(p[2 * j], p[2 * j + 1]);
#pragma unroll
            for (int nt = 0; nt < 8; ++nt) {
                o[nt] = mma16(*(const bf16x8*)(vt + j * 4096 + (16 * nt + n) * 32 + 8 * q), pb, o[nt]);
            }
        }
    }
    const float g0 = sigmoidf_(bf1(proj[m * PLD + C_AG + head]));
#pragma unroll
    for (int nt = 0; nt < 8; ++nt) *(f32x4*)(yaf + m * 2048 + head * 128 + 16 * nt + 4 * q) = o[nt] * g0;
    LDS_WAIT(); asm volatile("" ::: "memory");
    unsigned long long* sel = (unsigned long long*)(F.ws + WS_SEL);
#pragma unroll
    for (int t2 = 0; t2 < 2; ++t2) {
        const int t = tA + t2, blk = t >> 5, nb = lane;
        float imp = 2.f * PS[t2 * 128 + 2 * nb] + PS[t2 * 128 + 2 * nb + 1]; if (nb > 0) imp += PS[t2 * 128 + 2 * nb - 1];
        const bool forced = (nb == 0) || (nb == blk) || (nb == blk - 1);
        const float val = forced ? __builtin_inff() : (nb <= blk ? imp : NEG_INF);
        const int rank = rank64(val, lane, PS + 256);
        const unsigned long long msk = __ballot(rank < 8 && nb <= blk);
        if (lane == 0) sel[((size_t)b * SEQ + t) * 2 + g] = msk;
    }
    LDS_WAIT(); asm volatile("" ::: "memory");
}

__device__ __forceinline__ void win_attn_unit(Frame& F, int b, int g, int tb) {
    const int lane = F.lane, n = lane & 15, q = lane >> 4, wave = F.wave;
    const int t0 = 32 * tb + 16 * (wave & 1), hp = wave >> 1;
    const int s_tok = t0 + n; const size_t m = (size_t)b * SEQ + s_tok;
    const bf16* proj = (const bf16*)(F.ws + WS_PROJ); const bf16* qs = (const bf16*)(F.ws + WS_QS);
    const char* ksrc = (const char*)(F.ws + WS_KWT) + (size_t)(b * 2 + g) * SEQ * 256 + F.tid * 16;
    const char* vsrc = (const char*)(F.ws + WS_VWT) + (size_t)(b * 2 + g) * SEQ * 256 + F.tid * 16;
    const float* yaf = (const float*)(F.ws + WS_YAF); float* yaf2 = (float*)(F.ws + WS_YAF2);
    LAS unsigned char* ring = F.lds;
    const int h0 = g * 8 + 2 * hp;
    bf16x8 qf[2][4];
#pragma unroll
    for (int hd = 0; hd < 2; ++hd)
#pragma unroll
        for (int ks = 0; ks < 4; ++ks) qf[hd][ks] = *(const bf16x8*)(qs + m * 2048 + (h0 + hd) * 128 + 32 * ks + 8 * q);
    f32x4 o[2][8];
#pragma unroll
    for (int hd = 0; hd < 2; ++hd)
#pragma unroll
        for (int nt = 0; nt < 8; ++nt) o[hd][nt] = (f32x4){0.f, 0.f, 0.f, 0.f};
    float mrun[2] = {-1e30f, -1e30f}, lrun[2] = {0.f, 0.f};
    const int blo = tb >= 16 ? tb - 16 : 0, nb = tb - blo + 1;
#define WIN_DMA(bi, slot) do { \
        __builtin_amdgcn_global_load_lds((const unsigned*)(ksrc + (size_t)(bi) * 8192), (LAS unsigned*)(ring + (slot) * 16384 + wave * 1024), 16, 0, 0); \
        __builtin_amdgcn_global_load_lds((const unsigned*)(vsrc + (size_t)(bi) * 8192), (LAS unsigned*)(ring + (slot) * 16384 + 8192 + wave * 1024), 16, 0, 0); } while (0)
    asm volatile("s_barrier" ::: "memory");
    WIN_DMA(blo, 0);
    if (nb > 1) WIN_DMA(blo + 1, 1);
    for (int i = 0; i < nb; ++i) {
        const int bi = blo + i, slot = i % 3;
        if (i + 1 < nb) asm volatile("s_waitcnt vmcnt(2)\n\ts_barrier" ::: "memory"); else asm volatile("s_waitcnt vmcnt(0)\n\ts_barrier" ::: "memory");
        if (i + 2 < nb) WIN_DMA(bi + 2, (i + 2) % 3);
        const LAS unsigned char* kl = ring + slot * 16384 + (n * 32 + 8 * q) * 2; const LAS unsigned char* vl = kl + 8192;
        f32x4 s[2][2];
#pragma unroll
        for (int tl = 0; tl < 2; ++tl) {
            s[0][tl] = (f32x4){0.f, 0.f, 0.f, 0.f}; s[1][tl] = (f32x4){0.f, 0.f, 0.f, 0.f};
#pragma unroll
            for (int ks = 0; ks < 4; ++ks) { const bf16x8 kf = *(const LAS bf16x8*)(kl + tl * 4096 + ks * 1024);
                s[0][tl] = mma16(kf, qf[0][ks], s[0][tl]); s[1][tl] = mma16(kf, qf[1][ks], s[1][tl]); }
        }
        const bool interior = (32 * bi >= t0 - 496) && (32 * bi + 31 <= t0);
#pragma unroll
        for (int tl = 0; tl < 2; ++tl)
#pragma unroll
            for (int r = 0; r < 4; ++r) {
                const int key = 32 * bi + 16 * tl + 4 * q + r;
                const bool ok = interior || (key <= s_tok && s_tok - key < 512);
                s[0][tl][r] = ok ? s[0][tl][r] * (ATT_SCALE * LOG2E) : NEG_INF; s[1][tl][r] = ok ? s[1][tl][r] * (ATT_SCALE * LOG2E) : NEG_INF;
            }
        bf16x8 pb[2];
#pragma unroll
        for (int hd = 0; hd < 2; ++hd) {
            float tm = xor_max_q(fmaxf(max4(s[hd][0]), max4(s[hd][1])));
            const float mnew = fmaxf(mrun[hd], tm);
            const float alpha = __builtin_amdgcn_exp2f(mrun[hd] - mnew);
#pragma unroll
            for (int tl = 0; tl < 2; ++tl)
#pragma unroll
                for (int r = 0; r < 4; ++r) s[hd][tl][r] = __builtin_amdgcn_exp2f(s[hd][tl][r] - mnew);
            const float ps = xor_sum_q(sum4(s[hd][0]) + sum4(s[hd][1]));
            lrun[hd] = lrun[hd] * alpha + ps; mrun[hd] = mnew;
#pragma unroll
            for (int nt = 0; nt < 8; ++nt) o[hd][nt] = o[hd][nt] * alpha;
            pb[hd] = pack_p(s[hd][0], s[hd][1]);
        }
#pragma unroll
        for (int nt = 0; nt < 8; ++nt) {
            const bf16x8 vf = *(const LAS bf16x8*)(vl + nt * 1024);
            o[0][nt] = mma16(vf, pb[0], o[0][nt]); o[1][nt] = mma16(vf, pb[1], o[1][nt]);
        }
    }
#undef WIN_DMA
#pragma unroll
    for (int hd = 0; hd < 2; ++hd) {
        const float g2 = sigmoidf_(bf1(proj[m * PLD + C_AG + 32 + h0 + hd])) / lrun[hd];
#pragma unroll
        for (int nt = 0; nt < 8; ++nt) { const size_t off = m * 2048 + (h0 + hd) * 128 + 16 * nt + 4 * q; *(f32x4*)(yaf2 + off) = *(const f32x4*)(yaf + off) + o[hd][nt] * g2; }
    }
}

__device__ __forceinline__ void sel_load(Frame& F, int b, int g, int s_tok, bf16x8 (&qf)[4], unsigned long long& mk) {
    const int lane = F.lane, n = lane & 15, q = lane >> 4, head = g * 8 + (n & 7);
    const size_t m = (size_t)b * SEQ + s_tok;
    const bf16* qs = (const bf16*)(F.ws + WS_QS);
#pragma unroll
    for (int ks = 0; ks < 4; ++ks) qf[ks] = *(const bf16x8*)(qs + m * 2048 + head * 128 + 32 * ks + 8 * q);
    mk = ((const unsigned long long*)(F.ws + WS_SEL))[m * 2 + g];
}
__device__ __forceinline__ void sel_attn_item(Frame& F, int b, int g, int s_tok, bf16x8 (&qfio)[4], unsigned long long& mkio, bool has_next, int nb, int ng, int ns) {
    const int lane = F.lane, n = lane & 15, q = lane >> 4, head = g * 8 + (n & 7);
    const size_t m = (size_t)b * SEQ + s_tok;
    const bf16* proj = (const bf16*)(F.ws + WS_PROJ);
    const bf16* kbase = (const bf16*)(F.ws + WS_KST) + (size_t)(b * 2 + g) * SEQ * 128 + n * 32 + 8 * q;
    const bf16* vT = (const bf16*)(F.ws + WS_VST) + (size_t)(b * 2 + g) * 128 * SEQ + n * 32 + 8 * q;
    const float* yaf = (const float*)(F.ws + WS_YAF2); bf16* Y = (bf16*)(F.ws + WS_Y);
    bf16x8 qf[4];
#pragma unroll
    for (int ks = 0; ks < 4; ++ks) qf[ks] = qfio[ks];
    const unsigned long long mk = mkio;
    unsigned mlo = (unsigned)__builtin_amdgcn_readfirstlane((int)(unsigned)mk), mhi = (unsigned)__builtin_amdgcn_readfirstlane((int)(unsigned)(mk >> 32));
    unsigned long long mask = ((unsigned long long)mhi << 32) | mlo;
    int blk[8]; bool bok[8];
#pragma unroll
    for (int i = 0; i < 8; ++i) { bok[i] = mask != 0ull; blk[i] = bok[i] ? __builtin_ctzll(mask) : 0; mask &= mask - 1; }
    const f32x4 yprev0 = *(const f32x4*)(yaf + m * 2048 + head * 128 + 4 * q);
    const float gpre = bf1(proj[m * PLD + C_AG + 16 + head]);
    f32x4 p[8][2];
    float mx = -1e30f;
#pragma unroll
    for (int i = 0; i < 8; ++i) {
#pragma unroll
        for (int tl = 0; tl < 2; ++tl) {
            f32x4 a = {0.f, 0.f, 0.f, 0.f};
            const bf16* kr = kbase + (2 * blk[i] + tl) * 2048;
#pragma unroll
            for (int ks = 0; ks < 4; ++ks) a = mma16(*(const bf16x8*)(kr + 512 * ks), qf[ks], a);
#pragma unroll
            for (int r = 0; r < 4; ++r) { const int key = 32 * blk[i] + 16 * tl + 4 * q + r; a[r] = (bok[i] && key <= s_tok) ? a[r] * (ATT_SCALE * LOG2E) : NEG_INF; }
            p[i][tl] = a; mx = fmaxf(mx, max4(a));
        }
    }
    mx = xor_max_q(mx);
    float l = 0.f;
#pragma unroll
    for (int i = 0; i < 8; ++i)
#pragma unroll
        for (int tl = 0; tl < 2; ++tl) {
#pragma unroll
            for (int r = 0; r < 4; ++r) p[i][tl][r] = __builtin_amdgcn_exp2f(p[i][tl][r] - mx);
            l += sum4(p[i][tl]);
        }
    l = xor_sum_q(l);
    f32x4 o[8];
#pragma unroll
    for (int nt = 0; nt < 8; ++nt) o[nt] = (f32x4){0.f, 0.f, 0.f, 0.f};
#pragma unroll
    for (int i = 0; i < 8; ++i) {
        const bf16x8 pb = pack_p(p[i][0], p[i][1]);
#pragma unroll
        for (int nt = 0; nt < 8; ++nt) o[nt] = mma16(*(const bf16x8*)(vT + blk[i] * 4096 + nt * 512), pb, o[nt]);
    }
    if (has_next) sel_load(F, nb, ng, ns, qfio, mkio);
    const float g1 = sigmoidf_(gpre) / l;
    if (n < 8) {
#pragma unroll
        for (int nt = 0; nt < 8; ++nt) {
            const f32x4 pr = nt == 0 ? yprev0 : *(const f32x4*)(yaf + m * 2048 + head * 128 + 16 * nt + 4 * q);
            const f32x4 v = pr + o[nt] * g1;
            *(u32x2*)(Y + m * 4096 + head * 128 + 16 * nt + 4 * q) = (u32x2){pk2(v[0], v[1]), pk2(v[2], v[3])};
        }
    }
}

__device__ __forceinline__ void hgrn_finalize(Frame& F, const Args& A, int l) {
    const bf16* proj = (const bf16*)(F.ws + WS_PROJ); const float* ohg = (const float*)(F.ws + WS_OHG); bf16* Y = (bf16*)(F.ws + WS_Y);
    const float* ng = (const float*)ain_(A, I_HGNG) + (size_t)l * 1024;
    const int lane = F.lane;
    float ngv[16];
#pragma unroll
    for (int e = 0; e < 16; ++e) ngv[e] = ng[16 * lane + e];
    for (int m0 = F.gw; m0 < NTOK; m0 += 2 * F.NGW) {
        const int m1 = m0 + F.NGW; const bool ok1 = m1 < NTOK; const int mr[2] = {m0, ok1 ? m1 : m0};
        f32x4 v[2][4]; u32x4 ga[2], gb[2];
#pragma unroll
        for (int r = 0; r < 2; ++r) { const float* orow = ohg + (size_t)mr[r] * 1024 + 16 * lane;
#pragma unroll
            for (int j = 0; j < 4; ++j) v[r][j] = *(const f32x4*)(orow + 4 * j);
            ga[r] = *(const u32x4*)(proj + (size_t)mr[r] * PLD + C_HG + 16 * lane); gb[r] = *(const u32x4*)(proj + (size_t)mr[r] * PLD + C_HG + 16 * lane + 8); }
#pragma unroll
        for (int r = 0; r < 2; ++r) {
            float ss = 0.f;
#pragma unroll
            for (int j = 0; j < 4; ++j) ss += (v[r][j].x * v[r][j].x + v[r][j].y * v[r][j].y) + (v[r][j].z * v[r][j].z + v[r][j].w * v[r][j].w);
            ss += __shfl_xor(ss, 1); ss += __shfl_xor(ss, 2); ss += __shfl_xor(ss, 4);
            const float rms = 1.f / sqrtf(ss * (1.f / 128.f) + RMS_EPS);
            const unsigned gw_[8] = {ga[r].x, ga[r].y, ga[r].z, ga[r].w, gb[r].x, gb[r].y, gb[r].z, gb[r].w};
            unsigned ow[8];
#pragma unroll
            for (int e = 0; e < 8; ++e) {
                const float a0 = v[r][e >> 1][(2 * e) & 3] * rms * ngv[2 * e] * siluf_(bflo(gw_[e]));
                const float a1 = v[r][e >> 1][(2 * e + 1) & 3] * rms * ngv[2 * e + 1] * siluf_(bfhi(gw_[e]));
                ow[e] = pk2(a0, a1);
            }
            if (r == 0 || ok1) { bf16* d = Y + (size_t)mr[r] * 4096 + 2048 + 16 * lane;
                *(u32x4*)d = (u32x4){ow[0], ow[1], ow[2], ow[3]}; *(u32x4*)(d + 8) = (u32x4){ow[4], ow[5], ow[6], ow[7]}; }
        }
    }
}
using pg8::Unit;
struct SchedTile {
    pg8::TileOrder T; int G, c; const char* A; const char* B; unsigned lda, ldb; int nt;
    __device__ __forceinline__ bool next(int i, Unit& u) const {
        int pm, pn; if (!T.tile((long)i * G + c, pm, pn)) return false;
        u.A = A + (size_t)pm * 256 * lda; u.B = B + (size_t)pn * 256 * ldb; u.rows = nullptr; u.nt = nt; u.epi = 1; u.pm = pm; u.pn = pn; u.aux = 0; u.nvalid = 256; u.rowbase = pm * 256; u.shift = 0; return true;
    }
};
struct SchedP1 {
    pg8::TileOrder T; int G, c; const char* A; const char* B;
    __device__ __forceinline__ bool next(int i, Unit& u) const {
        int pm, pn; if (!T.tile((long)i * G + c, pm, pn)) return false;
        if (pn == 34) pn = 82;
        u.A = A + (size_t)pm * 256 * 8192; u.B = B + (size_t)pn * 256 * (WLD * 2); u.rows = nullptr; u.nt = 64; u.epi = 1; u.pm = pm; u.pn = pn; u.aux = 0; u.nvalid = 256; u.rowbase = pm * 256; u.shift = 0; return true;
    }
};
struct SchedMerge {
    pg8::TileOrder T; int G, c; const char* A; const char* B;
    __device__ __forceinline__ bool next(int i, Unit& u) const {
        const int ti = i / 3, seg = i - 3 * ti; int pm, pn; if (!T.tile((long)ti * G + c, pm, pn)) return false;
        const size_t koff = seg == 0 ? 0 : (seg == 1 ? 4096 : 6144);
        u.A = A + (size_t)pm * 256 * 8192 + koff; u.B = B + (size_t)pn * 256 * (WLD * 2) + koff; u.rows = nullptr; u.nt = seg == 0 ? 32 : 16; u.epi = 1; u.pm = pm; u.pn = pn; u.aux = seg;
        u.nvalid = 256; u.rowbase = pm * 256; u.shift = 0; return true;
    }
};
struct SchedPool {
    int G, c; const char* A; const char* B;
    __device__ __forceinline__ bool next(int i, Unit& u) const {
        const int L = i * G + c; if (L >= 256) return false; const int pm = L >> 2, g = L & 3;
        u.A = A + (size_t)pm * 256 * 2048 + g * 512; u.B = B + (size_t)g * 256 * 512; u.rows = nullptr; u.nt = 4; u.epi = 1; u.pm = pm; u.pn = 0; u.aux = g; u.nvalid = 256; u.rowbase = pm * 256; u.shift = 0; return true;
    }
};
struct SchedRouter {
    int G, c; const char* A; const char* B;
    __device__ __forceinline__ bool next(int i, Unit& u) const {
        const int L = i * G + c; if (L >= 256) return false; const int pm = L >> 2, kq = L & 3;
        u.A = A + (size_t)pm * 256 * 8192 + kq * 2048; u.B = B + kq * 2048; u.rows = nullptr; u.nt = 16; u.epi = 1; u.pm = pm; u.pn = 0; u.aux = kq; u.nvalid = 256; u.rowbase = pm * 256; u.shift = 0; return true;
    }
};
__device__ __forceinline__ void moe_find(const volatile LAS int* tab, int et, int& e, int& tile, int& nvalid) {
    const volatile LAS unsigned short* et2e = (const volatile LAS unsigned short*)(tab + 132);
    const int ee = __builtin_amdgcn_readfirstlane((int)et2e[et]);
    e = ee; tile = __builtin_amdgcn_readfirstlane(et - tab[ee]); const int cnt = __builtin_amdgcn_readfirstlane(tab[65 + ee]);
    nvalid = cnt - tile * 256 < 256 ? cnt - tile * 256 : 256;
}
struct SchedMoe1 {
    int G, c; const volatile LAS int* tab; const char* hb; const char* w13; const char* ws13; const int* plist; int ldbB, ntk;
    __device__ __forceinline__ bool next(int i, Unit& u) const {
        const int L = i * G + c, T = __builtin_amdgcn_readfirstlane(tab[64]);
        if (L >= T + 128) return false;
        u.A = hb; u.nt = ntk; u.epi = 1; u.pn = 0;
        if (L < T) { int e, tile, nv; moe_find(tab, L, e, tile, nv); u.B = w13 + (size_t)e * 256 * ldbB; u.rows = plist + (size_t)e * PCAP + tile * 256; u.nvalid = nv; u.shift = 3; u.rowbase = L * 256; u.pm = -1; u.aux = e; }
        else { const int sh = L - T, pm = sh >> 1, j = sh & 1; u.B = ws13 + (size_t)j * 256 * ldbB; u.rows = nullptr; u.nvalid = 256; u.shift = 0; u.rowbase = pm * 256; u.pm = pm; u.aux = j; }
        return true;
    }
};
struct SchedMoe2 {
    int G, c; const volatile LAS int* tab; const char* hd; const char* w2; const int* plist;
    __device__ __forceinline__ bool next(int i, Unit& u) const {
        const int L = i * G + c, T = __builtin_amdgcn_readfirstlane(tab[64]);
        if (L >= T * 16) return false;
        int e, tile, nv; moe_find(tab, L >> 4, e, tile, nv); const int pn = L & 15;
        u.A = hd + (size_t)(L >> 4) * 256 * 256; u.B = w2 + ((size_t)e * 4096 + pn * 256) * 256; u.rows = plist + (size_t)e * PCAP + tile * 256; u.nvalid = nv; u.shift = 0; u.rowbase = 0; u.nt = 2; u.epi = 1; u.pm = -1; u.pn = pn; u.aux = e;
        return true;
    }
};

typedef const f32x4 (&AccRef)[2][2][4][2];
struct EpiStoreBf16 {
    static constexpr bool PERM = true, I8 = false, PAIR64 = false;
    bf16* O; int ldc;
    __device__ __forceinline__ void operator()(AccRef acc, const Unit& u, int wr, int wc, int fr, int fq, const LAS int* rowsl) const {
        const int row0 = u.pm * 256 + wr * 64 + fr, col0 = u.pn * 256 + wc * 32 + 8 * fq;
#pragma unroll
        for (int ai = 0; ai < 2; ++ai)
#pragma unroll
            for (int m = 0; m < 4; ++m) { bf16* rowp = O + (size_t)(row0 + ai * 128 + m * 16) * ldc + col0;
#pragma unroll
                for (int bj = 0; bj < 2; ++bj) { const f32x4 v0 = acc[ai][bj][m][0], v1 = acc[ai][bj][m][1];
                    u32x4 w; w.x = pg8::cvt_pk_bf16(v0[0], v0[1]); w.y = pg8::cvt_pk_bf16(v0[2], v0[3]); w.z = pg8::cvt_pk_bf16(v1[0], v1[1]); w.w = pg8::cvt_pk_bf16(v1[2], v1[3]);
                    *(u32x4*)(rowp + bj * 128) = w; } }
    }
};
struct EpiStoreI8 {
    static constexpr bool PERM = true, I8 = true, PAIR64 = false;
    bf16* O; int ldc; const float* rs; const float* cs;
    __device__ __forceinline__ void operator()(AccRef acc, const Unit& u, int wr, int wc, int fr, int fq, const LAS int* rowsl) const {
        const int row0 = u.pm * 256 + wr * 64 + fr, col0 = u.pn * 256 + wc * 32 + 8 * fq;
        f32x4 c0[2], c1[2];
#pragma unroll
        for (int bj = 0; bj < 2; ++bj) { c0[bj] = *(const f32x4*)(cs + col0 + bj * 128); c1[bj] = *(const f32x4*)(cs + col0 + bj * 128 + 4); }
        float rr[2][4];
#pragma unroll
        for (int ai = 0; ai < 2; ++ai)
#pragma unroll
            for (int m = 0; m < 4; ++m) rr[ai][m] = rs[row0 + ai * 128 + m * 16];
#pragma unroll
        for (int ai = 0; ai < 2; ++ai)
#pragma unroll
            for (int m = 0; m < 4; ++m) { const int row = row0 + ai * 128 + m * 16; const float r = rr[ai][m]; bf16* rowp = O + (size_t)row * ldc + col0;
#pragma unroll
                for (int bj = 0; bj < 2; ++bj) { const pg8::i32x4 i0 = __builtin_bit_cast(pg8::i32x4, acc[ai][bj][m][0]), i1 = __builtin_bit_cast(pg8::i32x4, acc[ai][bj][m][1]);
                    u32x4 w; w.x = pg8::cvt_pk_bf16((float)i0[0] * r * c0[bj][0], (float)i0[1] * r * c0[bj][1]); w.y = pg8::cvt_pk_bf16((float)i0[2] * r * c0[bj][2], (float)i0[3] * r * c0[bj][3]);
                    w.z = pg8::cvt_pk_bf16((float)i1[0] * r * c1[bj][0], (float)i1[1] * r * c1[bj][1]); w.w = pg8::cvt_pk_bf16((float)i1[2] * r * c1[bj][2], (float)i1[3] * r * c1[bj][3]);
                    *(u32x4*)(rowp + bj * 128) = w; } }
    }
};
struct EpiPool {
    static constexpr bool PERM = true, I8 = false, PAIR64 = false;
    bf16* Y; const float* scale;
    __device__ __forceinline__ void operator()(AccRef acc, const Unit& u, int wr, int wc, int fr, int fq, const LAS int* rowsl) const {
        const int row0 = u.pm * 256 + wr * 64 + fr, col0 = u.aux * 256 + wc * 32 + 8 * fq;
        f32x4 sc[2][2];
#pragma unroll
        for (int bj = 0; bj < 2; ++bj) { sc[bj][0] = *(const f32x4*)(scale + col0 + bj * 128); sc[bj][1] = *(const f32x4*)(scale + col0 + bj * 128 + 4); }
#pragma unroll
        for (int ai = 0; ai < 2; ++ai)
#pragma unroll
            for (int m = 0; m < 4; ++m) { bf16* rowp = Y + (size_t)(row0 + ai * 128 + m * 16) * 4096 + 3072 + col0;
#pragma unroll
                for (int bj = 0; bj < 2; ++bj) { const f32x4 v0 = acc[ai][bj][m][0] * sc[bj][0], v1 = acc[ai][bj][m][1] * sc[bj][1];
                    u32x4 w; w.x = pg8::cvt_pk_bf16(v0[0], v0[1]); w.y = pg8::cvt_pk_bf16(v0[2], v0[3]); w.z = pg8::cvt_pk_bf16(v1[0], v1[1]); w.w = pg8::cvt_pk_bf16(v1[2], v1[3]);
                    *(u32x4*)(rowp + bj * 128) = w; } }
    }
};
struct EpiMerge {
    static constexpr bool PERM = true, I8 = false, PAIR64 = false;
    const bf16* proj; bf16* scr; bf16* merged;
    __device__ __forceinline__ void operator()(AccRef acc, const Unit& u, int wr, int wc, int fr, int fq, const LAS int* rowsl) const {
        const int seg = u.aux; const int gcol = C_GA + seg * 4096;
        const int row0 = u.pm * 256 + wr * 64 + fr, col0 = u.pn * 256 + wc * 32 + 8 * fq;
#pragma unroll
        for (int ai = 0; ai < 2; ++ai)
#pragma unroll
            for (int m = 0; m < 4; ++m) { const size_t row = (size_t)(row0 + ai * 128 + m * 16);
#pragma unroll
                for (int bj = 0; bj < 2; ++bj) { const int col = col0 + bj * 128;
                    const u32x4 gw = *(const u32x4*)(proj + row * PLD + gcol + col);
                    f32x4 v0 = acc[ai][bj][m][0], v1 = acc[ai][bj][m][1];
                    v0[0] *= sigmoidf_(bflo(gw.x)); v0[1] *= sigmoidf_(bfhi(gw.x)); v0[2] *= sigmoidf_(bflo(gw.y)); v0[3] *= sigmoidf_(bfhi(gw.y));
                    v1[0] *= sigmoidf_(bflo(gw.z)); v1[1] *= sigmoidf_(bfhi(gw.z)); v1[2] *= sigmoidf_(bflo(gw.w)); v1[3] *= sigmoidf_(bfhi(gw.w));
                    bf16* sp = scr + row * 4096 + col;
                    if (seg > 0) { const u32x4 pw = *(const u32x4*)sp; v0 = v0 + (f32x4){bflo(pw.x), bfhi(pw.x), bflo(pw.y), bfhi(pw.y)}; v1 = v1 + (f32x4){bflo(pw.z), bfhi(pw.z), bflo(pw.w), bfhi(pw.w)}; }
                    if (seg < 2) { u32x4 w; w.x = pg8::cvt_pk_bf16(v0[0], v0[1]); w.y = pg8::cvt_pk_bf16(v0[2], v0[3]); w.z = pg8::cvt_pk_bf16(v1[0], v1[1]); w.w = pg8::cvt_pk_bf16(v1[2], v1[3]); *(u32x4*)sp = w; }
                    else { u32x4 w; w.x = pg8::cvt_pk_bf16(v0[0], v0[1]); w.y = pg8::cvt_pk_bf16(v0[2], v0[3]); w.z = pg8::cvt_pk_bf16(v1[0], v1[1]); w.w = pg8::cvt_pk_bf16(v1[2], v1[3]);
                        *(u32x4*)(merged + row * 4096 + col) = w; } } }
    }
};
struct SchedMerge8 {
    pg8::TileOrder T; int G, c; const char* A; const char* B;
    __device__ __forceinline__ bool next(int i, Unit& u) const {
        const int ti = i / 3, seg = i - 3 * ti; int pm, pn; if (!T.tile((long)ti * G + c, pm, pn)) return false;
        const size_t koff = seg == 0 ? 0 : (seg == 1 ? 2048 : 3072);
        u.A = A + (size_t)pm * 256 * 4096 + koff; u.B = B + (size_t)pn * 256 * W8LD + koff; u.rows = nullptr; u.nt = seg == 0 ? 16 : 8; u.epi = 1; u.pm = pm; u.pn = pn; u.aux = seg;
        u.nvalid = 256; u.rowbase = pm * 256; u.shift = 0; return true;
    }
};
struct EpiMerge8 {
    static constexpr bool PERM = true, I8 = true, PAIR64 = false;
    const bf16* proj; bf16* scr; bf16* merged; const float* rs; const float* cs;
    __device__ __forceinline__ void operator()(AccRef acc, const Unit& u, int wr, int wc, int fr, int fq, const LAS int* rowsl) const {
        const int seg = u.aux; const int gcol = C_GA + seg * 4096;
        const int row0 = u.pm * 256 + wr * 64 + fr, col0 = u.pn * 256 + wc * 32 + 8 * fq;
        const float* rsv = rs + seg * 16384; const float* csv = cs + seg * 4096;
        f32x4 c0[2], c1[2];
#pragma unroll
        for (int bj = 0; bj < 2; ++bj) { c0[bj] = *(const f32x4*)(csv + col0 + bj * 128); c1[bj] = *(const f32x4*)(csv + col0 + bj * 128 + 4); }
#pragma unroll
        for (int aim = 0; aim < 4; ++aim) { const int ai = aim >> 1, mb = (aim & 1) * 2;
            u32x4 gw[4][2], pw[4][2]; float rr[4];
#pragma unroll
            for (int m = mb; m < mb + 2; ++m) { const size_t row = (size_t)(row0 + ai * 128 + m * 16); rr[m] = rsv[row];
#pragma unroll
                for (int bj = 0; bj < 2; ++bj) { const int col = col0 + bj * 128; gw[m][bj] = *(const u32x4*)(proj + row * PLD + gcol + col);
                    pw[m][bj] = seg > 0 ? *(const u32x4*)(scr + row * 4096 + col) : (u32x4){0u, 0u, 0u, 0u}; } }
#pragma unroll
            for (int m = mb; m < mb + 2; ++m) { const size_t row = (size_t)(row0 + ai * 128 + m * 16); const float r = rr[m];
#pragma unroll
                for (int bj = 0; bj < 2; ++bj) { const int col = col0 + bj * 128; const u32x4 g = gw[m][bj], pv = pw[m][bj];
                    const pg8::i32x4 i0 = __builtin_bit_cast(pg8::i32x4, acc[ai][bj][m][0]), i1 = __builtin_bit_cast(pg8::i32x4, acc[ai][bj][m][1]);
                    f32x4 v0 = (f32x4){(float)i0[0], (float)i0[1], (float)i0[2], (float)i0[3]} * c0[bj] * r, v1 = (f32x4){(float)i1[0], (float)i1[1], (float)i1[2], (float)i1[3]} * c1[bj] * r;
                    v0[0] *= sigmoidf_(bflo(g.x)); v0[1] *= sigmoidf_(bfhi(g.x)); v0[2] *= sigmoidf_(bflo(g.y)); v0[3] *= sigmoidf_(bfhi(g.y));
                    v1[0] *= sigmoidf_(bflo(g.z)); v1[1] *= sigmoidf_(bfhi(g.z)); v1[2] *= sigmoidf_(bflo(g.w)); v1[3] *= sigmoidf_(bfhi(g.w));
                    v0 = v0 + (f32x4){bflo(pv.x), bfhi(pv.x), bflo(pv.y), bfhi(pv.y)}; v1 = v1 + (f32x4){bflo(pv.z), bfhi(pv.z), bflo(pv.w), bfhi(pv.w)};
                    u32x4 w; w.x = pg8::cvt_pk_bf16(v0[0], v0[1]); w.y = pg8::cvt_pk_bf16(v0[2], v0[3]); w.z = pg8::cvt_pk_bf16(v1[0], v1[1]); w.w = pg8::cvt_pk_bf16(v1[2], v1[3]);
                    if (seg < 2) *(u32x4*)(scr + row * 4096 + col) = w; else *(u32x4*)(merged + row * 4096 + col) = w; } }
        }
    }
};
struct EpiRes8 {
    static constexpr bool PERM = true, I8 = true, PAIR64 = false;
    const bf16* h; bf16* out; const float* rs; const float* cs;
    __device__ __forceinline__ void operator()(AccRef acc, const Unit& u, int wr, int wc, int fr, int fq, const LAS int* rowsl) const {
        const int row0 = u.pm * 256 + wr * 64 + fr, col0 = u.pn * 256 + wc * 32 + 8 * fq;
        f32x4 c0[2], c1[2];
#pragma unroll
        for (int bj = 0; bj < 2; ++bj) { c0[bj] = *(const f32x4*)(cs + col0 + bj * 128); c1[bj] = *(const f32x4*)(cs + col0 + bj * 128 + 4); }
#pragma unroll
        for (int ai = 0; ai < 2; ++ai) {
            u32x4 hw[4][2]; float rr[4];
#pragma unroll
            for (int m = 0; m < 4; ++m) { const int row = row0 + ai * 128 + m * 16; rr[m] = rs[row];
#pragma unroll
                for (int bj = 0; bj < 2; ++bj) hw[m][bj] = *(const u32x4*)(h + (size_t)row * 4096 + col0 + bj * 128); }
#pragma unroll
            for (int m = 0; m < 4; ++m) { const int row = row0 + ai * 128 + m * 16; const float r = rr[m]; const size_t off = (size_t)row * 4096 + col0;
#pragma unroll
                for (int bj = 0; bj < 2; ++bj) { const u32x4 hv = hw[m][bj];
                    const pg8::i32x4 i0 = __builtin_bit_cast(pg8::i32x4, acc[ai][bj][m][0]), i1 = __builtin_bit_cast(pg8::i32x4, acc[ai][bj][m][1]);
                    const f32x4 v0 = (f32x4){bflo(hv.x), bfhi(hv.x), bflo(hv.y), bfhi(hv.y)} * DN_ALPHA + (f32x4){(float)i0[0], (float)i0[1], (float)i0[2], (float)i0[3]} * c0[bj] * r;
                    const f32x4 v1 = (f32x4){bflo(hv.z), bfhi(hv.z), bflo(hv.w), bfhi(hv.w)} * DN_ALPHA + (f32x4){(float)i1[0], (float)i1[1], (float)i1[2], (float)i1[3]} * c1[bj] * r;
                    u32x4 w; w.x = pg8::cvt_pk_bf16(v0[0], v0[1]); w.y = pg8::cvt_pk_bf16(v0[2], v0[3]); w.z = pg8::cvt_pk_bf16(v1[0], v1[1]); w.w = pg8::cvt_pk_bf16(v1[2], v1[3]);
                    *(u32x4*)(out + off + bj * 128) = w; } }
        }
    }
};
struct EpiResF32 {
    static constexpr bool PERM = true, I8 = false, PAIR64 = false;
    const bf16* h; bf16* out;
    __device__ __forceinline__ void operator()(AccRef acc, const Unit& u, int wr, int wc, int fr, int fq, const LAS int* rowsl) const {
        const int row0 = u.pm * 256 + wr * 64 + fr, col0 = u.pn * 256 + wc * 32 + 8 * fq;
#pragma unroll
        for (int ai = 0; ai < 2; ++ai) {
            u32x4 hws[4][2];
#pragma unroll
            for (int m = 0; m < 4; ++m)
#pragma unroll
                for (int bj = 0; bj < 2; ++bj) hws[m][bj] = *(const u32x4*)(h + (size_t)(row0 + ai * 128 + m * 16) * 4096 + col0 + bj * 128);
#pragma unroll
            for (int m = 0; m < 4; ++m) { const size_t off = (size_t)(row0 + ai * 128 + m * 16) * 4096 + col0;
#pragma unroll
                for (int bj = 0; bj < 2; ++bj) { const u32x4 hw = hws[m][bj];
                    const f32x4 v0 = (f32x4){bflo(hw.x), bfhi(hw.x), bflo(hw.y), bfhi(hw.y)} * DN_ALPHA + acc[ai][bj][m][0], v1 = (f32x4){bflo(hw.z), bfhi(hw.z), bflo(hw.w), bfhi(hw.w)} * DN_ALPHA + acc[ai][bj][m][1];
                    u32x4 w; w.x = pg8::cvt_pk_bf16(v0[0], v0[1]); w.y = pg8::cvt_pk_bf16(v0[2], v0[3]); w.z = pg8::cvt_pk_bf16(v1[0], v1[1]); w.w = pg8::cvt_pk_bf16(v1[2], v1[3]);
                    *(u32x4*)(out + off + bj * 128) = w; } }
        }
    }
};
struct EpiRouter {
    static constexpr bool PERM = false, I8 = false, PAIR64 = false;
    float* part;
    __device__ __forceinline__ void operator()(AccRef acc, const Unit& u, int wr, int wc, int fr, int fq, const LAS int* rowsl) const {
        if (wc >= 2) return;
        const int row0 = u.pm * 256 + wr * 64 + fr, col0 = wc * 32 + 4 * fq;
        float* base = part + (size_t)u.aux * NTOK * 64;
#pragma unroll
        for (int ai = 0; ai < 2; ++ai)
#pragma unroll
            for (int m = 0; m < 4; ++m)
#pragma unroll
                for (int n = 0; n < 2; ++n) *(f32x4*)(base + (size_t)(row0 + ai * 128 + m * 16) * 64 + col0 + n * 16) = acc[ai][0][m][n];
    }
};
struct EpiGLU {
    static constexpr bool PERM = true, I8 = false, PAIR64 = false;
    bf16* hd; bf16* hs; const float* pgate; const int* plist;
    __device__ __forceinline__ void operator()(AccRef acc, const Unit& u, int wr, int wc, int fr, int fq, const LAS int* rowsl) const {
        const bool moe = u.rows != nullptr;
        const float* gp = moe ? pgate + (u.rows - plist) : pgate;
        bf16* base = moe ? hd + (size_t)u.rowbase * 128 : hs + (size_t)u.rowbase * 256 + u.aux * 128;
        const int ld = moe ? 128 : 256;
        const int colw = wc * 32 + 8 * fq, rl = wr * 64 + fr;
#pragma unroll
        for (int ai = 0; ai < 2; ++ai)
#pragma unroll
            for (int m = 0; m < 4; ++m) { const int r = ai * 128 + m * 16 + rl;
                if (r < u.nvalid) {
                    const float gt = moe ? gp[r] : 1.f;
                    const f32x4 a0 = acc[ai][0][m][0], a1 = acc[ai][0][m][1], b0 = acc[ai][1][m][0], b1 = acc[ai][1][m][1];
                    u32x4 w;
                    w.x = pg8::cvt_pk_bf16(siluf_(a0[0]) * b0[0] * gt, siluf_(a0[1]) * b0[1] * gt); w.y = pg8::cvt_pk_bf16(siluf_(a0[2]) * b0[2] * gt, siluf_(a0[3]) * b0[3] * gt);
                    w.z = pg8::cvt_pk_bf16(siluf_(a1[0]) * b1[0] * gt, siluf_(a1[1]) * b1[1] * gt); w.w = pg8::cvt_pk_bf16(siluf_(a1[2]) * b1[2] * gt, siluf_(a1[3]) * b1[3] * gt);
                    *(u32x4*)(base + r * ld + colw) = w; } }
    }
};
struct EpiGLU8 {
    static constexpr bool PERM = true, I8 = true, PAIR64 = false;
    bf16* hd; bf16* hs; const float* pgate; const int* plist; const float* rs; const float* cs13; const float* css13;
    __device__ __forceinline__ void operator()(AccRef acc, const Unit& u, int wr, int wc, int fr, int fq, const LAS int* rowsl) const {
        const bool moe = u.rows != nullptr;
        const float* gp = moe ? pgate + (u.rows - plist) : pgate;
        bf16* base = moe ? hd + (size_t)u.rowbase * 128 : hs + (size_t)u.rowbase * 256 + u.aux * 128;
        const int ld = moe ? 128 : 256;
        const int colw = wc * 32 + 8 * fq, rl = wr * 64 + fr;
        const float* cb = moe ? cs13 + u.aux * 256 : css13 + u.aux * 256;
        const f32x4 c1a = *(const f32x4*)(cb + colw), c1b = *(const f32x4*)(cb + colw + 4), c3a = *(const f32x4*)(cb + 128 + colw), c3b = *(const f32x4*)(cb + 128 + colw + 4);
        float gts[2][4], rscs[2][4];
        {
            int tok[2][4];
#pragma unroll
            for (int ai = 0; ai < 2; ++ai)
#pragma unroll
                for (int m = 0; m < 4; ++m) { const int r = ai * 128 + m * 16 + rl; const int rc = r < u.nvalid ? r : 0;
                    tok[ai][m] = moe ? (u.rows[rc] >> 3) : (u.rowbase + rc); gts[ai][m] = moe ? gp[rc] : 1.f; }
#pragma unroll
            for (int ai = 0; ai < 2; ++ai)
#pragma unroll
                for (int m = 0; m < 4; ++m) rscs[ai][m] = rs[tok[ai][m]];
        }
#pragma unroll
        for (int ai = 0; ai < 2; ++ai)
#pragma unroll
            for (int m = 0; m < 4; ++m) { const int r = ai * 128 + m * 16 + rl;
                if (r < u.nvalid) {
                    const float gt = gts[ai][m];
                    const float rsc = rscs[ai][m];
                    const pg8::i32x4 a0 = __builtin_bit_cast(pg8::i32x4, acc[ai][0][m][0]), a1 = __builtin_bit_cast(pg8::i32x4, acc[ai][0][m][1]), b0 = __builtin_bit_cast(pg8::i32x4, acc[ai][1][m][0]), b1 = __builtin_bit_cast(pg8::i32x4, acc[ai][1][m][1]);
                    float o[8];
#pragma unroll
                    for (int e = 0; e < 4; ++e) { o[e] = siluf_((float)a0[e] * rsc * c1a[e]) * ((float)b0[e] * rsc * c3a[e]) * gt; o[4 + e] = siluf_((float)a1[e] * rsc * c1b[e]) * ((float)b1[e] * rsc * c3b[e]) * gt; }
                    u32x4 w; w.x = pg8::cvt_pk_bf16(o[0], o[1]); w.y = pg8::cvt_pk_bf16(o[2], o[3]); w.z = pg8::cvt_pk_bf16(o[4], o[5]); w.w = pg8::cvt_pk_bf16(o[6], o[7]);
                    *(u32x4*)(base + r * ld + colw) = w; } }
    }
};
struct EpiPair {
    static constexpr bool PERM = true, I8 = false, PAIR64 = true;
    signed char* yp;
    __device__ __forceinline__ void operator()(AccRef acc, const Unit& u, int wr, int wc, int fr, int fq, const LAS int* rowsl) const {
        const int colw = u.pn * 256 + wc * 64;
        const int col16 = colw + 16 * ((fq >> 1) + 2 * (fq & 1));
#pragma unroll
        for (int ai = 0; ai < 2; ++ai)
#pragma unroll
            for (int m = 0; m < 4; ++m) { const int r = ai * 128 + wr * 64 + m * 16 + fr;
                unsigned lo[2], hi[2];
#pragma unroll
                for (int bj = 0; bj < 2; ++bj) { const f32x4 v0 = acc[ai][bj][m][0] * 16.f, v1 = acc[ai][bj][m][1] * 16.f;
                    int a = 0, b = 0;
                    a = __builtin_amdgcn_cvt_pk_fp8_f32(v0[0], v0[1], a, false); a = __builtin_amdgcn_cvt_pk_fp8_f32(v0[2], v0[3], a, true);
                    b = __builtin_amdgcn_cvt_pk_fp8_f32(v1[0], v1[1], b, false); b = __builtin_amdgcn_cvt_pk_fp8_f32(v1[2], v1[3], b, true);
                    lo[bj] = (unsigned)a; hi[bj] = (unsigned)b; }
                const auto s0 = __builtin_amdgcn_permlane16_swap(lo[0], lo[1], false, false), s1 = __builtin_amdgcn_permlane16_swap(hi[0], hi[1], false, false);
                const u32x4 w = {s0[0], s1[0], s0[1], s1[1]};
                if (r < u.nvalid && yp) *(u32x4*)(yp + (size_t)rowsl[r] * 4096 + col16) = w; }
    }
};

__device__ __forceinline__ void ln_finish8(f32x4 (&v)[16], const f32x4 (&gv)[16], const f32x4 (&bv)[16], float* orow, bf16* brow, int lane, signed char* qrow = nullptr, float* qscale = nullptr) {
    float s1 = 0.f;
#pragma unroll
    for (int j = 0; j < 16; ++j) s1 += (v[j].x + v[j].y) + (v[j].z + v[j].w);
    const float mean = wave_sum(s1) * (1.f / DM); float s2 = 0.f;
#pragma unroll
    for (int j = 0; j < 16; ++j) { v[j] = v[j] - mean; s2 += (v[j].x * v[j].x + v[j].y * v[j].y) + (v[j].z * v[j].z + v[j].w * v[j].w); }
    const float rstd = 1.f / sqrtf(wave_sum(s2) * (1.f / DM) + LN_EPS);
    float amax = 0.f;
#pragma unroll
    for (int j = 0; j < 8; ++j) { const int c = 8 * (lane + 64 * j);
        const f32x4 o0 = v[2 * j] * rstd * gv[2 * j] + bv[2 * j], o1 = v[2 * j + 1] * rstd * gv[2 * j + 1] + bv[2 * j + 1];
        v[2 * j] = o0; v[2 * j + 1] = o1;
        amax = fmaxf(amax, fmaxf(fmaxf(fmaxf(fabsf(o0.x), fabsf(o0.y)), fmaxf(fabsf(o0.z), fabsf(o0.w))), fmaxf(fmaxf(fabsf(o1.x), fabsf(o1.y)), fmaxf(fabsf(o1.z), fabsf(o1.w)))));
        if (orow) { *(f32x4*)(orow + c) = o0; *(f32x4*)(orow + c + 4) = o1; }
        *(u32x4*)(brow + c) = (u32x4){pk2(o0.x, o0.y), pk2(o0.z, o0.w), pk2(o1.x, o1.y), pk2(o1.z, o1.w)}; }
    if (qrow) {
#pragma unroll
        for (int o = 1; o < 64; o <<= 1) amax = fmaxf(amax, __shfl_xor(amax, o));
        const float sc = fmaxf(amax, 1e-20f) * (1.f / 127.f), inv = 1.f / sc;
        if (lane == 0) *qscale = sc;
#pragma unroll
        for (int j = 0; j < 8; ++j) { const int c = 8 * (lane + 64 * j); const f32x4 a = v[2 * j] * inv, b = v[2 * j + 1] * inv;
            const unsigned lo = ((unsigned)(int)rintf(a.x) & 255u) | (((unsigned)(int)rintf(a.y) & 255u) << 8) | (((unsigned)(int)rintf(a.z) & 255u) << 16) | (((unsigned)(int)rintf(a.w) & 255u) << 24);
            const unsigned hi = ((unsigned)(int)rintf(b.x) & 255u) | (((unsigned)(int)rintf(b.y) & 255u) << 8) | (((unsigned)(int)rintf(b.z) & 255u) << 16) | (((unsigned)(int)rintf(b.w) & 255u) << 24);
            *(u32x2*)(qrow + c) = (u32x2){lo, hi}; }
    }
}
__device__ __forceinline__ void ln_finish8p(f32x4 (&v)[16], const float* g, const float* bta, float* orow, bf16* brow, int lane, signed char* qrow = nullptr, float* qscale = nullptr) {
    float s1 = 0.f;
#pragma unroll
    for (int j = 0; j < 16; ++j) s1 += (v[j].x + v[j].y) + (v[j].z + v[j].w);
    const float mean = wave_sum(s1) * (1.f / DM); float s2 = 0.f;
#pragma unroll
    for (int j = 0; j < 16; ++j) { v[j] = v[j] - mean; s2 += (v[j].x * v[j].x + v[j].y * v[j].y) + (v[j].z * v[j].z + v[j].w * v[j].w); }
    const float rstd = 1.f / sqrtf(wave_sum(s2) * (1.f / DM) + LN_EPS);
    float amax = 0.f;
#pragma unroll
    for (int hb2 = 0; hb2 < 2; ++hb2) {
        f32x4 gq[8], bq[8];
#pragma unroll
        for (int jj = 0; jj < 4; ++jj) { const int c = 8 * (lane + 64 * (4 * hb2 + jj)); gq[2 * jj] = *(const f32x4*)(g + c); gq[2 * jj + 1] = *(const f32x4*)(g + c + 4); bq[2 * jj] = *(const f32x4*)(bta + c); bq[2 * jj + 1] = *(const f32x4*)(bta + c + 4); }
#pragma unroll
        for (int jj = 0; jj < 4; ++jj) { const int j = 4 * hb2 + jj; const int c = 8 * (lane + 64 * j);
            const f32x4 o0 = v[2 * j] * rstd * gq[2 * jj] + bq[2 * jj], o1 = v[2 * j + 1] * rstd * gq[2 * jj + 1] + bq[2 * jj + 1];
            v[2 * j] = o0; v[2 * j + 1] = o1;
            amax = fmaxf(amax, fmaxf(fmaxf(fmaxf(fabsf(o0.x), fabsf(o0.y)), fmaxf(fabsf(o0.z), fabsf(o0.w))), fmaxf(fmaxf(fabsf(o1.x), fabsf(o1.y)), fmaxf(fabsf(o1.z), fabsf(o1.w)))));
            if (orow) { *(f32x4*)(orow + c) = o0; *(f32x4*)(orow + c + 4) = o1; }
            *(u32x4*)(brow + c) = (u32x4){pk2(o0.x, o0.y), pk2(o0.z, o0.w), pk2(o1.x, o1.y), pk2(o1.z, o1.w)}; }
    }
    if (qrow) {
#pragma unroll
        for (int o = 1; o < 64; o <<= 1) amax = fmaxf(amax, __shfl_xor(amax, o));
        const float sc = fmaxf(amax, 1e-20f) * (1.f / 127.f), inv = 1.f / sc;
        if (lane == 0) *qscale = sc;
#pragma unroll
        for (int j = 0; j < 8; ++j) { const int c = 8 * (lane + 64 * j); const f32x4 a = v[2 * j] * inv, b = v[2 * j + 1] * inv;
            const unsigned lo = ((unsigned)(int)rintf(a.x) & 255u) | (((unsigned)(int)rintf(a.y) & 255u) << 8) | (((unsigned)(int)rintf(a.z) & 255u) << 16) | (((unsigned)(int)rintf(a.w) & 255u) << 24);
            const unsigned hi = ((unsigned)(int)rintf(b.x) & 255u) | (((unsigned)(int)rintf(b.y) & 255u) << 8) | (((unsigned)(int)rintf(b.z) & 255u) << 16) | (((unsigned)(int)rintf(b.w) & 255u) << 24);
            *(u32x2*)(qrow + c) = (u32x2){lo, hi}; }
    }
}
__device__ __forceinline__ void ld_gb8(f32x4 (&gv)[16], f32x4 (&bv)[16], const float* g, const float* bta, int lane) {
#pragma unroll
    for (int j = 0; j < 8; ++j) { const int c = 8 * (lane + 64 * j); gv[2 * j] = *(const f32x4*)(g + c); gv[2 * j + 1] = *(const f32x4*)(g + c + 4); bv[2 * j] = *(const f32x4*)(bta + c); bv[2 * j + 1] = *(const f32x4*)(bta + c + 4); }
}
__device__ __forceinline__ void ld_row8(f32x4 (&v)[16], const bf16* row, int lane) {
#pragma unroll
    for (int j = 0; j < 8; ++j) { const u32x4 w = *(const u32x4*)(row + 8 * (lane + 64 * j));
        v[2 * j] = (f32x4){bflo(w.x), bfhi(w.x), bflo(w.y), bfhi(w.y)}; v[2 * j + 1] = (f32x4){bflo(w.z), bfhi(w.z), bflo(w.w), bfhi(w.w)}; }
}
__device__ __forceinline__ void lnin_phase(Frame& F, const Args& A) {
    const float* x = (const float*)ain_(A, I_X); const int lane = F.lane;
    f32x4 gv[16], bv[16]; ld_gb8(gv, bv, (const float*)ain_(A, I_LNIN_G), (const float*)ain_(A, I_LNIN_B), lane);
    for (int m = F.gw; m < NTOK; m += F.NGW) {
        f32x4 v[16];
#pragma unroll
        for (int j = 0; j < 8; ++j) { const float* p = x + (size_t)m * DM + 8 * (lane + 64 * j); v[2 * j] = *(const f32x4*)p; v[2 * j + 1] = *(const f32x4*)(p + 4); }
        ln_finish8(v, gv, bv, nullptr, (bf16*)(F.ws + WS_HB) + (size_t)m * DM, lane, (signed char*)(F.ws + WS_HB8) + (size_t)m * DM, (float*)(F.ws + WS_HBS) + m);
    }
}
__device__ __forceinline__ void ln1_phase(Frame& F, const Args& A, int l) {
    const bf16* ypre = (const bf16*)(F.ws + WS_YPRE); const int lane = F.lane;
    f32x4 gv[16], bv[16]; ld_gb8(gv, bv, (const float*)ain_(A, I_LN1G) + (size_t)l * DM, (const float*)ain_(A, I_LN1B) + (size_t)l * DM, lane);
    for (int m = F.gw; m < NTOK; m += F.NGW) {
        f32x4 v[16];
        ld_row8(v, ypre + (size_t)m * DM, lane);
        ln_finish8(v, gv, bv, nullptr, (bf16*)(F.ws + WS_HB) + (size_t)m * DM, lane,
                   (signed char*)(F.ws + WS_HB8) + (size_t)m * DM, (float*)(F.ws + WS_HBS) + m);
    }
}
__device__ __forceinline__ void ln2_phase(Frame& F, const Args& A, int l) {
    const bf16* ypre = (const bf16*)(F.ws + WS_YPRE); const signed char* yp = (const signed char*)(F.ws + WS_YPAIR); const int lane = F.lane;
    const float* g = (const float*)ain_(A, I_LN2G) + (size_t)l * DM; const float* bta = (const float*)ain_(A, I_LN2B) + (size_t)l * DM;
    for (int m = F.gw; m < NTOK; m += F.NGW) {
        f32x4 v[16];
        ld_row8(v, ypre + (size_t)m * DM, lane);
#pragma unroll
        for (int s = 0; s < 8; ++s) { const signed char* pr = yp + ((size_t)m * 8 + s) * DM + 8 * lane;
#pragma unroll
            for (int j = 0; j < 8; ++j) { const u32x2 w = *(const u32x2*)(pr + 512 * j);
                v[2 * j] = v[2 * j] + (f32x4){__builtin_amdgcn_cvt_f32_fp8((int)w.x, 0), __builtin_amdgcn_cvt_f32_fp8((int)w.x, 1), __builtin_amdgcn_cvt_f32_fp8((int)w.x, 2), __builtin_amdgcn_cvt_f32_fp8((int)w.x, 3)} * 0.0625f;
                v[2 * j + 1] = v[2 * j + 1] + (f32x4){__builtin_amdgcn_cvt_f32_fp8((int)w.y, 0), __builtin_amdgcn_cvt_f32_fp8((int)w.y, 1), __builtin_amdgcn_cvt_f32_fp8((int)w.y, 2), __builtin_amdgcn_cvt_f32_fp8((int)w.y, 3)} * 0.0625f; } }
        ln_finish8p(v, g, bta, l == DEPTH - 1 ? A.out + (size_t)m * DM : nullptr, (bf16*)(F.ws + WS_HB) + (size_t)m * DM, lane,
                   l == DEPTH - 1 ? nullptr : (signed char*)(F.ws + WS_HB8) + (size_t)m * DM, (float*)(F.ws + WS_HBS) + m);
    }
}
__device__ __forceinline__ void routing_phase(Frame& F, const Args& A, int l) {
    const float* part = (const float*)(F.ws + WS_LOGIT); const float* rb = (const float*)ain_(A, I_RB) + l * NEXP;
    int* plist = (int*)(F.ws + WS_PLIST); float* pgate = (float*)(F.ws + WS_PGS);
    unsigned* cnt = (unsigned*)(F.ctl + CW_CNT + l * 4096);
    const int lane = F.lane;
    const float bias = rb[lane];
    for (int m = F.gw; m < NTOK; m += F.NGW) {
        float lg = 0.f;
#pragma unroll
        for (int kq = 0; kq < 4; ++kq) lg += part[((size_t)kq * NTOK + m) * 64 + lane];
        const float score = sigmoidf_(lg), val = score + bias;
        const int rank = rank64(val, lane, (LAS float*)F.lds + F.wave * 64);
        const bool selb = rank < TOPK;
        const float ssum = wave_sum(selb ? score : 0.f);
        if (selb) {
            const unsigned pos = __hip_atomic_fetch_add(cnt + lane * 64, 1u, __ATOMIC_RELAXED, __HIP_MEMORY_SCOPE_AGENT);
            plist[(size_t)lane * PCAP + pos] = m * 8 + rank;
            pgate[(size_t)lane * PCAP + pos] = score / ssum * 2.5f;
        }
    }
}
__device__ __forceinline__ void moe_table(Frame& F, int l, volatile LAS int* tab) {
    __syncthreads();
    if (F.tid < 64) tab[65 + F.tid] = (int)__hip_atomic_load((unsigned*)(F.ctl + CW_CNT + l * 4096) + F.tid * 64, __ATOMIC_RELAXED, __HIP_MEMORY_SCOPE_AGENT);
    __syncthreads();
    if (F.tid == 0) { int s = 0; for (int e = 0; e < NEXP; ++e) { tab[e] = s; s += (tab[65 + e] + 255) >> 8; } tab[64] = s; }
    __syncthreads();
    if (F.tid < 64) { volatile LAS unsigned short* et2e = (volatile LAS unsigned short*)(tab + 132); const int t0 = tab[F.tid], t1 = tab[F.tid + 1]; for (int t = t0; t < t1; ++t) et2e[t] = (unsigned short)F.tid; }
    __syncthreads();
}

template <int KLEN>
__device__ __forceinline__ void quant_rows(Frame& F, const bf16* src, int ld, int koff, int nrows, signed char* dst, int ldd, float* sc_out) {
    const int lane = F.lane; constexpr int NJ = KLEN / 512;
    for (int n = F.gw; n < nrows; n += F.NGW) {
        f32x4 v[2 * NJ]; float amax = 0.f;
#pragma unroll
        for (int j = 0; j < NJ; ++j) { const u32x4 w = *(const u32x4*)(src + (size_t)n * ld + koff + 8 * (lane + 64 * j));
            v[2 * j] = (f32x4){bflo(w.x), bfhi(w.x), bflo(w.y), bfhi(w.y)}; v[2 * j + 1] = (f32x4){bflo(w.z), bfhi(w.z), bflo(w.w), bfhi(w.w)};
            amax = fmaxf(amax, fmaxf(fmaxf(fmaxf(fabsf(v[2 * j].x), fabsf(v[2 * j].y)), fmaxf(fabsf(v[2 * j].z), fabsf(v[2 * j].w))), fmaxf(fmaxf(fabsf(v[2 * j + 1].x), fabsf(v[2 * j + 1].y)), fmaxf(fabsf(v[2 * j + 1].z), fabsf(v[2 * j + 1].w))))); }
#pragma unroll
        for (int o = 1; o < 64; o <<= 1) amax = fmaxf(amax, __shfl_xor(amax, o));
        const float sc = fmaxf(amax, 1e-30f) * (1.f / 127.f), inv = 1.f / sc;
        if (lane == 0) sc_out[n] = sc;
#pragma unroll
        for (int j = 0; j < NJ; ++j) { const int c = 8 * (lane + 64 * j); const f32x4 a = v[2 * j] * inv, b = v[2 * j + 1] * inv;
            const unsigned lo = ((unsigned)(int)rintf(a.x) & 255u) | (((unsigned)(int)rintf(a.y) & 255u) << 8) | (((unsigned)(int)rintf(a.z) & 255u) << 16) | (((unsigned)(int)rintf(a.w) & 255u) << 24);
            const unsigned hi = ((unsigned)(int)rintf(b.x) & 255u) | (((unsigned)(int)rintf(b.y) & 255u) << 8) | (((unsigned)(int)rintf(b.z) & 255u) << 16) | (((unsigned)(int)rintf(b.w) & 255u) << 24);
            *(u32x2*)(dst + (size_t)n * ldd + koff + c) = (u32x2){lo, hi}; }
    }
}
__device__ __forceinline__ void quant_weights(Frame& F) {
    float* cs = (float*)(F.ws + WS_W8S);
    quant_rows<4096>(F, (const bf16*)(F.ws + WS_WIN), WLD, 0, PLD, (signed char*)(F.ws + WS_W8), W8LD, cs);
    quant_rows<4096>(F, (const bf16*)(F.ws + WS_W13), WLD, 0, NEXP * 256, (signed char*)(F.ws + WS_W138), W8LD, cs + 32768);
    quant_rows<4096>(F, (const bf16*)(F.ws + WS_WS13), WLD, 0, 512, (signed char*)(F.ws + WS_WS138), W8LD, cs + 65536);
    quant_rows<2048>(F, (const bf16*)(F.ws + WS_WUP), WLD, 0, 4096, (signed char*)(F.ws + WS_WUP8), W8LD, cs + 69632);
    quant_rows<1024>(F, (const bf16*)(F.ws + WS_WUP), WLD, 2048, 4096, (signed char*)(F.ws + WS_WUP8), W8LD, cs + 69632 + 4096);
    quant_rows<1024>(F, (const bf16*)(F.ws + WS_WUP), WLD, 3072, 4096, (signed char*)(F.ws + WS_WUP8), W8LD, cs + 69632 + 8192);
    quant_rows<4096>(F, (const bf16*)(F.ws + WS_WO), WLD, 0, 4096, (signed char*)(F.ws + WS_WO8), W8LD, cs + 81920);
}
__device__ __forceinline__ void quant_y(Frame& F) {
    float* rs = (float*)(F.ws + WS_HBS) + 16384;
    quant_rows<2048>(F, (const bf16*)(F.ws + WS_Y), 4096, 0, NTOK, (signed char*)(F.ws + WS_Y8), 4096, rs);
    quant_rows<1024>(F, (const bf16*)(F.ws + WS_Y), 4096, 2048, NTOK, (signed char*)(F.ws + WS_Y8), 4096, rs + 16384);
    quant_rows<1024>(F, (const bf16*)(F.ws + WS_Y), 4096, 3072, NTOK, (signed char*)(F.ws + WS_Y8), 4096, rs + 32768);
}
__device__ __forceinline__ void quant_merged(Frame& F) {
    quant_rows<4096>(F, (const bf16*)(F.ws + WS_MERGED), 4096, 0, NTOK, (signed char*)(F.ws + WS_M8), 4096, (float*)(F.ws + WS_HBS) + 65536);
}
#ifndef MK_ONE_LAUNCH
#define MK_ONE_LAUNCH 1
#endif
#ifndef MK_SP2
#define MK_SP2 true
#endif
#ifndef MK_REPEAT
#define MK_REPEAT 0
#endif
#define NREP(k) ((((MK_REPEAT) >> (k)) & 1) ? 2 : 1)
#ifndef MK_P0_NOSTORE
#define MK_P0_NOSTORE 0
#endif
#ifndef MK_SUBREP
#define MK_SUBREP 0
#endif
#ifndef MK_P1_ALLI8
#define MK_P1_ALLI8 0
#endif
#ifndef MK_HGRN_MMA
#define MK_HGRN_MMA 1
#endif
#ifndef MK_P12_NOSTORE
#define MK_P12_NOSTORE 0
#endif
#ifndef MK_PH_MASK
#define MK_PH_MASK 0x3fff
#endif
constexpr int NPH = 14;
constexpr int TAB_OFF = MISC_OFF + 128;

__device__ __forceinline__ void run_layer(Frame& F, const Args& args, const int l, const int lo, const int hi, const XcdBarrier& bar, volatile LAS int* tab,
                                          unsigned char* ws0, const int bid0, const int G0, const int wave0, const int vcu0) {
        const int pb = l * NPH;
        { int t_ = threadIdx.x; asm volatile("" : "+v"(t_)); F.tid = t_; F.lane = t_ & 63; }
        int bid = bid0, G = G0, wv_ = wave0, vc_ = vcu0; asm volatile("" : "+s"(bid), "+s"(G), "+s"(wv_), "+s"(vc_));
        F.wave = wv_; F.vcu = vc_; F.G = G; F.gw = vc_ * NWAVES + wv_; F.NGW = G * NWAVES;
        GAS unsigned char* wsg_ = (GAS unsigned char*)ws0; asm volatile("" : "+s"(wsg_)); unsigned char* ws = (unsigned char*)wsg_; F.ws = ws; F.ctl = (gu32*)(ws + WS_CTL);
#define IN(k) ((((MK_PH_MASK) >> (k)) & 1) && lo <= pb + (k) && pb + (k) < hi)
#define SEAM(k) do { if (IN(k) && pb + (k) + 1 < hi) xcd_barrier(bar); } while (0)
        if (IN(0)) for (int rep = 0; rep < NREP(0); ++rep) { if (rep) __syncthreads(); p0_phase(F, args, l, rep == 0 || !(MK_P0_NOSTORE)); if (l == 0) lnin_phase(F, args); }
        SEAM(0);
        if (IN(1)) for (int rep = 0; rep < NREP(1); ++rep) {
            if (rep) { __syncthreads(); int t_ = threadIdx.x; asm volatile("" : "+v"(t_)); F.tid = t_; F.lane = t_ & 63; }
            quant_weights(F);
            xcd_barrier(bar);
#if MK_P1_ALLI8
            {
                SchedTile S; S.T.init(64, PLD / 256); S.G = G; S.c = bid; S.A = (const char*)(ws + WS_HB8); S.B = (const char*)(ws + WS_W8); S.lda = 4096; S.ldb = W8LD; S.nt = 32;
                EpiStoreI8 E{(bf16*)(ws + WS_PROJ), PLD, (const float*)(ws + WS_HBS), (const float*)(ws + WS_W8S)};
                pg8::gemm_phase<EpiStoreI8, SchedTile, false, true, MK_SP2>(F.lds, 4096u, (unsigned)W8LD, S, E);
            }
        }
#else
            {
                SchedTile S; S.T.init(64, 48); S.G = G; S.c = bid; S.A = (const char*)(ws + WS_HB8); S.B = (const char*)(ws + WS_W8); S.lda = 4096; S.ldb = W8LD; S.nt = 32;
                EpiStoreI8 E{(bf16*)(ws + WS_PROJ) + C_GA, PLD, (const float*)(ws + WS_HBS), (const float*)(ws + WS_W8S)};
                pg8::gemm_phase<EpiStoreI8, SchedTile, false, true, MK_SP2>(F.lds, 4096u, (unsigned)W8LD, S, E);
            }
            __syncthreads();
            {
                SchedP1 S; S.T.init(64, 35); S.G = G; S.c = bid; S.A = (const char*)(ws + WS_HB); S.B = (const char*)(ws + WS_WIN);
                EpiStoreBf16 E{(bf16*)(ws + WS_PROJ), PLD};
                pg8::gemm_phase<EpiStoreBf16, SchedP1, false, true, MK_SP2>(F.lds, 8192u, (unsigned)(WLD * 2), S, E);
            }
        }
#endif
        SEAM(1);
        if (IN(2)) for (int rep = 0; rep < NREP(2); ++rep) {
            if (rep) { __syncthreads(); int t_ = threadIdx.x; asm volatile("" : "+v"(t_)); F.tid = t_; F.lane = t_ & 63; }
            for (int sr = 0; sr < ((MK_SUBREP & 1) ? 2 : 1); ++sr) { for (int u = bid; u < 256; u += G) { if (MK_HGRN_MMA) hgrn_unit_mma(F, args, l, u); else hgrn_unit(F, args, l, u); } __syncthreads(); }
            __syncthreads();
            for (int sr = 0; sr < ((MK_SUBREP & 2) ? 2 : 1); ++sr) { for (int u = bid; u < 256; u += G) compress_unit(F, u);
            for (int u = bid; u < 1024; u += G) vtrans_unit(F, u); }
            for (int sr = 0; sr < ((MK_SUBREP & 4) ? 2 : 1); ++sr) rope_pool_pass(F, rep == 0);
        }
        SEAM(2);
        if (IN(3)) for (int rep = 0; rep < NREP(3); ++rep) {
            if (rep) { __syncthreads(); int t_ = threadIdx.x; asm volatile("" : "+v"(t_)); F.tid = t_; F.lane = t_ & 63; }
#ifndef NO_CMP
            for (int sr = 0; sr < ((MK_SUBREP & 8) ? 2 : 1); ++sr) for (int u = bid; u < 2048; u += G) cmp_attn_item(F, u >> 8, (u >> 7) & 1, (u & 127) * 16 + 2 * F.wave, (LAS float*)F.lds + F.wave * 320);
#endif
            __syncthreads();
#ifndef NO_POOLG
            {
                SchedPool S{G, bid, (const char*)(ws + WS_MIXED), (const char*)(ws + WS_SMALL + SM_POOL)};
                EpiPool E{(bf16*)(ws + WS_Y), (const float*)ain_(args, I_POOLS) + (size_t)l * 1024};
                pg8::gemm_phase<EpiPool, SchedPool, false, true, MK_SP2>(F.lds, 2048u, 512u, S, E);
            }
#endif
#ifndef NO_FIN
            for (int sr = 0; sr < ((MK_SUBREP & 32) ? 2 : 1); ++sr) hgrn_finalize(F, args, l);
#endif
        }
        SEAM(3);
        if (IN(4)) for (int rep = 0; rep < NREP(4); ++rep) { for (int u = bid; u < 1024; u += G) win_attn_unit(F, u >> 7, (u >> 6) & 1, u & 63); __syncthreads(); }
        SEAM(4);
        if (IN(5)) for (int rep = 0; rep < NREP(5); ++rep) { { bf16x8 qfc[4]; unsigned long long mkc = 0ull; if (bid < 4096) sel_load(F, bid >> 9, (bid >> 8) & 1, (bid & 255) * 8 + F.wave, qfc, mkc);
              for (int u = bid; u < 4096; u += G) { const int un = u + G; sel_attn_item(F, u >> 9, (u >> 8) & 1, (u & 255) * 8 + F.wave, qfc, mkc, un < 4096, un >> 9, (un >> 8) & 1, (un & 255) * 8 + F.wave); } }
            xcd_barrier(bar); quant_y(F); }
        SEAM(5);
        if (IN(6)) for (int rep = 0; rep < NREP(6); ++rep) {
            if (rep) { __syncthreads(); int t_ = threadIdx.x; asm volatile("" : "+v"(t_)); F.tid = t_; F.lane = t_ & 63; }
            SchedMerge8 S; S.T.init(64, 16); S.G = G; S.c = bid; S.A = (const char*)(ws + WS_Y8); S.B = (const char*)(ws + WS_WUP8);
            EpiMerge8 E{(const bf16*)(ws + WS_PROJ), (bf16*)(ws + WS_YPRE), (bf16*)(ws + WS_MERGED), (const float*)(ws + WS_HBS) + 16384, (const float*)(ws + WS_W8S) + 69632};
            pg8::gemm_phase<EpiMerge8, SchedMerge8, false, true, MK_SP2>(F.lds, 4096u, (unsigned)W8LD, S, E);
            xcd_barrier(bar); quant_merged(F);
        }
        SEAM(6);
        if (IN(7)) for (int rep = 0; rep < NREP(7); ++rep) {
            if (rep) { __syncthreads(); int t_ = threadIdx.x; asm volatile("" : "+v"(t_)); F.tid = t_; F.lane = t_ & 63; }
            SchedTile S; S.T.init(64, 16); S.G = G; S.c = bid; S.A = (const char*)(ws + WS_M8); S.B = (const char*)(ws + WS_WO8); S.lda = 4096; S.ldb = W8LD; S.nt = 32;
            EpiRes8 E{(const bf16*)(ws + WS_HB), (bf16*)(ws + WS_YPRE), (const float*)(ws + WS_HBS) + 65536, (const float*)(ws + WS_W8S) + 81920};
            pg8::gemm_phase<EpiRes8, SchedTile, false, true, MK_SP2>(F.lds, 4096u, (unsigned)W8LD, S, E);
        }
        SEAM(7);
        if (IN(8)) for (int rep = 0; rep < NREP(8); ++rep) ln1_phase(F, args, l);
        SEAM(8);
        if (IN(9)) for (int rep = 0; rep < NREP(9); ++rep) {
            if (rep) { __syncthreads(); int t_ = threadIdx.x; asm volatile("" : "+v"(t_)); F.tid = t_; F.lane = t_ & 63; }
            SchedRouter S{G, bid, (const char*)(ws + WS_HB), (const char*)(ws + WS_ROUTER)};
            EpiRouter E{(float*)(ws + WS_LOGIT)};
            pg8::gemm_phase<EpiRouter, SchedRouter, false, true, MK_SP2>(F.lds, 8192u, (unsigned)(WLD * 2), S, E);
        }
        SEAM(9);
        if (IN(10)) routing_phase(F, args, l);
        SEAM(10);
        if (IN(11)) for (int rep = 0; rep < NREP(11); ++rep) {
            if (rep) { __syncthreads(); int t_ = threadIdx.x; asm volatile("" : "+v"(t_)); F.tid = t_; F.lane = t_ & 63; }
            moe_table(F, l, tab);
            SchedMoe1 S{G, bid, tab, (const char*)(ws + WS_HB8), (const char*)(ws + WS_W138), (const char*)(ws + WS_WS138), (const int*)(ws + WS_PLIST), W8LD, 32};
            EpiGLU8 E{(bf16*)(ws + WS_HD2), (bf16*)(ws + WS_HS), (const float*)(ws + WS_PGS), (const int*)(ws + WS_PLIST), (const float*)(ws + WS_HBS), (const float*)(ws + WS_W8S) + 32768, (const float*)(ws + WS_W8S) + 65536};
            pg8::gemm_phase<EpiGLU8, SchedMoe1, true, true, MK_SP2>(F.lds, 4096u, (unsigned)W8LD, S, E);
        }
        SEAM(11);
        if (IN(12)) for (int rep = 0; rep < NREP(12); ++rep) {
            if (rep) { __syncthreads(); int t_ = threadIdx.x; asm volatile("" : "+v"(t_)); F.tid = t_; F.lane = t_ & 63; }
            moe_table(F, l, tab);
#ifndef NO_MOE2
            {
                SchedMoe2 S{G, bid, tab, (const char*)(ws + WS_HD2), (const char*)(ws + WS_W2), (const int*)(ws + WS_PLIST)};
                EpiPair E{(MK_P12_NOSTORE && rep) ? (signed char*)nullptr : (signed char*)(ws + WS_YPAIR)};
                pg8::gemm_phase<EpiPair, SchedMoe2, false, true, MK_SP2, true>(F.lds, 256u, 256u, S, E);
            }
#endif
            __syncthreads();
#ifndef NO_SH2
            {
                SchedTile S; S.T.init(64, 16); S.G = G; S.c = bid; S.A = (const char*)(ws + WS_HS); S.B = (const char*)(ws + WS_WS2); S.lda = 512; S.ldb = 512; S.nt = 4;
                EpiResF32 E{(const bf16*)(ws + WS_HB), (bf16*)(ws + WS_YPRE)};
                pg8::gemm_phase<EpiResF32, SchedTile, false, true, MK_SP2>(F.lds, 512u, 512u, S, E);
            }
#endif
        }
        SEAM(12);
        if (IN(13)) for (int rep = 0; rep < NREP(13); ++rep) ln2_phase(F, args, l);
        SEAM(13);
#undef IN
#undef SEAM
}

__global__ void __launch_bounds__(NWAVES * 64, 2) mk_fwd(Args args) {
    extern __shared__ __attribute__((aligned(16))) unsigned char lds_raw[];
    Frame F;
    F.lds = (LAS unsigned char*)lds_raw;
    F.MISC = (volatile LAS unsigned*)(F.lds + MISC_OFF);
    F.tid = threadIdx.x; F.lane = F.tid & 63; F.wave = __builtin_amdgcn_readfirstlane(F.tid >> 6);
    F.G = gridDim.x; { const int bx = blockIdx.x; F.vcu = (F.G % 8 == 0) ? (bx % 8) * (F.G / 8) + bx / 8 : bx; }
    F.gw = F.vcu * NWAVES + F.wave; F.NGW = F.G * NWAVES;
    F.ws = args.ws; F.ctl = (gu32*)(args.ws + WS_CTL);
    const int bid0 = blockIdx.x, G0 = F.G, wave0 = F.wave, vcu0 = F.vcu;
    unsigned char* ws0 = args.ws;
    for (int u = F.tid; u < (LDS_BYTES - LDSCTL_OFF) / 4; u += NWAVES * 64) ((LAS unsigned*)(F.lds + LDSCTL_OFF))[u] = 0u;
    __syncthreads();
    const int lo = args.ph_lo, hi = args.ph_hi;
    XcdBarrier bar; bar.bar = (unsigned*)(F.ctl + CW_BAR); bar.x = 0; bar.st = nullptr;
    if (hi - lo > 1) bar = xcd_barrier_post((unsigned*)(F.ctl + CW_BAR), F.MISC + 8);
    volatile LAS int* tab = (volatile LAS int*)(F.lds + TAB_OFF);

    run_layer(F, args, 0, lo, hi, bar, tab, ws0, bid0, G0, wave0, vcu0);
    run_layer(F, args, 1, lo, hi, bar, tab, ws0, bid0, G0, wave0, vcu0);
}

extern "C" void kernel_launch(void* const* d_in, const int* in_sizes, int n_in, void* d_out, int out_size, void* d_ws, size_t ws_size, hipStream_t stream) {
    static int grid = 0;
    if (grid == 0) {
        if (n_in != 31 || out_size != NTOK * DM || ws_size < WS_END) { fprintf(stderr, "kernel_launch: unexpected shapes (n_in %d out %d ws %zu, need %zu)\n", n_in, out_size, ws_size, (size_t)WS_END); grid = -1; return; }
        int dev = 0, cus = 0, per_cu = 0;
        if (hipGetDevice(&dev) != hipSuccess || hipDeviceGetAttribute(&cus, hipDeviceAttributeMultiprocessorCount, dev) != hipSuccess) { grid = -1; return; }
        if (hipFuncSetAttribute((const void*)mk_fwd, hipFuncAttributeMaxDynamicSharedMemorySize, LDS_BYTES) != hipSuccess) { fprintf(stderr, "kernel_launch: hipFuncSetAttribute failed\n"); grid = -1; return; }
        if (hipOccupancyMaxActiveBlocksPerMultiprocessor(&per_cu, (const void*)mk_fwd, NWAVES * 64, LDS_BYTES) != hipSuccess || per_cu < 1)
            fprintf(stderr, "kernel_launch: occupancy query reports %d workgroups per CU\n", per_cu);
        (void)hipGetLastError();
        grid = cus;
    }
    if (grid < 0) return;
    if (hipMemsetAsync((char*)d_ws + WS_CTL, 0, CTL_ZERO_BYTES, stream) != hipSuccess) { fprintf(stderr, "kernel_launch: memset failed\n"); return; }
    Args a{};
    for (int i = 0; i < 31; ++i) a.in[i] = d_in[i];
    a.out = (float*)d_out; a.ws = (unsigned char*)d_ws;
#if MK_ONE_LAUNCH
    a.ph_lo = 0; a.ph_hi = DEPTH * NPH;
    hipLaunchKernelGGL(mk_fwd, dim3(grid), dim3(NWAVES * 64), LDS_BYTES, stream, a);
#else
    for (int p = 0; p < DEPTH * NPH; ++p) { a.ph_lo = p; a.ph_hi = p + 1; hipLaunchKernelGGL(mk_fwd, dim3(grid), dim3(NWAVES * 64), LDS_BYTES, stream, a); }
#endif
    const hipError_t le = hipPeekAtLastError();
    if (le != hipSuccess) fprintf(stderr, "kernel_launch: launch failed: %s\n", hipGetErrorName(le));
}
```
